# Optimizing an MI355X kernel written in HIP

```python
import math
import jax
import jax.numpy as jnp
from jax import lax
import numpy as np

D_MODEL = 1024
BATCH = 32
SEQ = 2048
DEPTH = 2
DEC_BATCH = 16
DEC_SEQ = 32
PAST_LEN = 1024

CHUNK = 64
N_LEFT_CHUNKS = 8
N_BAND = N_LEFT_CHUNKS + 1
BAND_ROWS = N_LEFT_CHUNKS * CHUNK
HEAD_DIM = 64
N_HEADS_A = 8
W_A = N_HEADS_A * HEAD_DIM
REL_CLIP = 128
N_HEADS_B = 8
W_B = N_HEADS_B * HEAD_DIM
W_C = 512
N_BLOCKS_C = 8
BLOCK_C = W_C // N_BLOCKS_C
CONV_W = 4
LRU_C = 8.0
PLE_DIM = 256
N_BRANCH = 3
ROPE_BASE = 10000.0
ALPHA = (2 * DEPTH) ** 0.25
BETA = (8 * DEPTH) ** -0.25
LN_EPS = 1e-5
NEG_INF = -1e30
SPLITS = [W_A] * 4 + [W_B] * 4 + [W_C] * 2 + [D_MODEL] * 3
N_IN = sum(SPLITS)

kernel_name = 'hybrid_chunk_stream_encoder_step'


def split_cols(u):
    out = []
    off = 0
    for w in SPLITS:
        out.append(u[..., off:off + w])
        off += w
    return out


def layer_norm(x, g, b):
    xf = x.astype(jnp.float32)
    mu = jnp.mean(xf, -1, keepdims=True)
    var = jnp.mean(jnp.square(xf - mu), -1, keepdims=True)
    y = (xf - mu) * lax.rsqrt(var + LN_EPS) * g.astype(jnp.float32) + b.astype(jnp.float32)
    return y.astype(x.dtype)


def group_norm_heads(y, g):
    b, t, h, d = y.shape
    yf = y.astype(jnp.float32)
    mu = jnp.mean(yf, -1, keepdims=True)
    var = jnp.mean(jnp.square(yf - mu), -1, keepdims=True)
    out = ((yf - mu) * lax.rsqrt(var + LN_EPS)).reshape(b, t, h * d) * g.astype(jnp.float32)
    return out.astype(y.dtype)


def rope(x, pos):
    half = HEAD_DIM // 2
    inv = ROPE_BASE ** (-jnp.arange(half, dtype=jnp.float32) / half)
    ang = pos.astype(jnp.float32)[:, None] * inv[None, :]
    c = jnp.cos(ang)[:, None, :]
    s = jnp.sin(ang)[:, None, :]
    xf = x.astype(jnp.float32)
    x1, x2 = xf[..., :half], xf[..., half:]
    return jnp.concatenate([x1 * c - x2 * s, x1 * s + x2 * c], -1).astype(x.dtype)


def rel_bias(table, qpos, kpos):
    idx = jnp.clip(qpos[:, None] - kpos[None, :], -REL_CLIP, REL_CLIP) + REL_CLIP
    return table.astype(jnp.float32)[:, idx]


def band_attention_prompt(q, k, v, table):
    b, s, h, d = q.shape
    nc = s // CHUNK
    qc = q.reshape(b, nc, CHUNK, h, d) * (d ** -0.5)
    pad = ((0, 0), (N_LEFT_CHUNKS, 0), (0, 0), (0, 0), (0, 0))
    kp = jnp.pad(k.reshape(b, nc, CHUNK, h, d), pad)
    vp = jnp.pad(v.reshape(b, nc, CHUNK, h, d), pad)
    scores = jnp.concatenate(
        [jnp.einsum('bcqhd,bckhd->bhcqk', qc, kp[:, o:o + nc]) for o in range(N_BAND)],
        axis=-1).astype(jnp.float32)
    qpos = N_LEFT_CHUNKS * CHUNK + jnp.arange(CHUNK)
    kpos = jnp.arange(N_BAND * CHUNK)
    scores = scores + rel_bias(table, qpos, kpos)[None, :, None]
    valid = (jnp.arange(nc)[:, None] + jnp.arange(N_BAND)[None, :]) >= N_LEFT_CHUNKS
    valid = jnp.repeat(valid, CHUNK, axis=1)
    scores = jnp.where(valid[None, None, :, None, :], scores, NEG_INF)
    probs = jax.nn.softmax(scores, axis=-1).astype(v.dtype)
    out = sum(jnp.einsum('bhcqk,bckhd->bcqhd', probs[..., o * CHUNK:(o + 1) * CHUNK], vp[:, o:o + nc])
              for o in range(N_BAND))
    return out.reshape(b, s, h, d)


def band_attention_sample(q, k, v, k_cache, v_cache, table):
    t = q.shape[1]
    c = k_cache.shape[1]
    d = q.shape[-1]
    keys = jnp.concatenate([k_cache.astype(k.dtype), k], axis=1)
    vals = jnp.concatenate([v_cache.astype(v.dtype), v], axis=1)
    qpos = PAST_LEN + jnp.arange(t)
    kpos = PAST_LEN - c + jnp.arange(c + t)
    scores = jnp.einsum('bqhd,bkhd->bhqk', q * (d ** -0.5), keys).astype(jnp.float32)
    scores = scores + rel_bias(table, qpos, kpos)[None]
    probs = jax.nn.softmax(scores, axis=-1).astype(v.dtype)
    return jnp.einsum('bhqk,bkhd->bqhd', probs, vals)


def retention(q, k, v, s0, blk):
    dt = q.dtype
    b, t, h, d = q.shape
    n = t // blk
    q = q.astype(jnp.float32).reshape(b, n, blk, h, d)
    k = k.astype(jnp.float32).reshape(b, n, blk, h, d)
    v = v.astype(jnp.float32).reshape(b, n, blk, h, d)
    log_g = jnp.log1p(-jnp.exp2(-5.0 - jnp.arange(h, dtype=jnp.float32)))
    i = jnp.arange(blk, dtype=jnp.float32)
    diff = i[:, None] - i[None, :]
    decay = jnp.where(diff >= 0, jnp.exp(log_g[:, None, None] * jnp.maximum(diff, 0.0)), 0.0)
    inner = jnp.einsum('bnihd,bnjhd->bnhij', q, k) * decay
    y_in = jnp.einsum('bnhij,bnjhe->bnihe', inner, v)
    zeta = jnp.exp(log_g[:, None] * (blk - 1.0 - i)[None, :])
    kv = jnp.einsum('bnjhd,bnjhe,hj->nbhde', k, v, zeta)
    g_blk = jnp.exp(log_g * blk)[None, :, None, None]

    def step(state, kv_n):
        return g_blk * state + kv_n, state

    s_final, s_prev = lax.scan(step, s0.astype(jnp.float32), kv)
    xi = jnp.exp(log_g[:, None] * (i + 1.0)[None, :])
    y_x = jnp.einsum('bnihd,nbhde,hi->bnihe', q, s_prev, xi)
    return (y_in + y_x).reshape(b, t, h, d).astype(dt), s_final.astype(s0.dtype)


def _lin_combine(e1, e2):
    a1, b1 = e1
    a2, b2 = e2
    return a1 * a2, a2 * b1 + b2


def rg_lru(xr, s_conv, s_lru, conv_w, conv_b, w_gate_a, b_gate_a, w_gate_x, b_gate_x, lru_lambda):
    b, t, w = xr.shape
    xpad = jnp.concatenate([s_conv.astype(xr.dtype), xr], axis=1)
    xc = conv_b + sum(xpad[:, j:j + t] * conv_w[j] for j in range(CONV_W))
    new_conv = xpad[:, t:].astype(s_conv.dtype)
    xb = xc.reshape(b, t, N_BLOCKS_C, BLOCK_C)
    r = jax.nn.sigmoid((jnp.einsum('btni,nij->btnj', xb, w_gate_a).reshape(b, t, w) + b_gate_a).astype(jnp.float32))
    ig = jax.nn.sigmoid((jnp.einsum('btni,nij->btnj', xb, w_gate_x).reshape(b, t, w) + b_gate_x).astype(jnp.float32))
    log_a = -LRU_C * r * jax.nn.softplus(-lru_lambda.astype(jnp.float32))
    a = jnp.exp(log_a)
    bx = jnp.sqrt(-jnp.expm1(2.0 * log_a)) * ig * xc.astype(jnp.float32)
    acc_a, acc_b = lax.associative_scan(_lin_combine, (a, bx), axis=1)
    h = acc_a * s_lru.astype(jnp.float32)[:, None, :] + acc_b
    return h.astype(xr.dtype), h[:, -1].astype(s_lru.dtype), new_conv


def layer(x, pe, pos, w_in, rel_table, gn_gain, conv_w, conv_b, w_gate_a, b_gate_a, w_gate_x, b_gate_x,
          lru_lambda, w_branch, w_out, ln_gain, ln_bias, w_ple, w_ple_gate,
          k_cache, v_cache, s_ret, s_conv, s_lru):
    b, t, _ = x.shape
    u = x @ w_in
    qa, ka, va, za, qb, kb, vb, zb, xr, zc, ga, gb, gc = split_cols(u)

    def heads(z):
        return z.reshape(b, t, -1, HEAD_DIM)

    qa, ka, va = heads(qa), heads(ka), heads(va)
    if k_cache is None:
        ya = band_attention_prompt(qa, ka, va, rel_table)
        rows = min(BAND_ROWS, t)
        new_k, new_v = ka[:, t - rows:], va[:, t - rows:]
        ret_blk = CHUNK
    else:
        ya = band_attention_sample(qa, ka, va, k_cache, v_cache, rel_table)
        new_k, new_v = ka, va
        ret_blk = t
    ya = ya.reshape(b, t, W_A) * jax.nn.silu(za)

    qb = rope(heads(qb), pos)
    kb = rope(heads(kb), pos) * (HEAD_DIM ** -0.5)
    yb, new_ret = retention(qb, kb, heads(vb), s_ret, ret_blk)
    yb = group_norm_heads(yb, gn_gain) * jax.nn.silu(zb)

    yc, new_lru, new_conv = rg_lru(xr, s_conv, s_lru, conv_w, conv_b, w_gate_a, b_gate_a,
                                   w_gate_x, b_gate_x, lru_lambda)
    yc = yc * jax.nn.silu(zc)

    merged = (jax.nn.sigmoid(ga) * (ya @ w_branch[0])
              + jax.nn.sigmoid(gb) * (yb @ w_branch[1])
              + jax.nn.sigmoid(gc) * (yc @ w_branch[2]))
    r = ALPHA * x + merged @ w_out
    r = r + jax.nn.sigmoid(r @ w_ple_gate) * (pe @ w_ple)
    return layer_norm(r, ln_gain, ln_bias), (new_k, new_v, new_ret, new_conv, new_lru)


def setup_inputs(seed: int = 0) -> dict:
    key = jax.random.key(seed)
    ks = iter(jax.random.split(key, 32))

    def nrm(shape, scale):
        return jax.random.normal(next(ks), shape, jnp.float32) * scale

    rows = min(BAND_ROWS, PAST_LEN)
    a0 = jax.random.uniform(next(ks), (DEPTH, W_C), jnp.float32, 0.9, 0.999)
    sig = a0 ** (1.0 / LRU_C)
    return {
        'x_prompt': nrm((BATCH, SEQ, D_MODEL), 1.0),
        'x_sample': nrm((DEC_BATCH, DEC_SEQ, D_MODEL), 1.0),
        'p_prompt': nrm((DEPTH, BATCH, SEQ, PLE_DIM), 1.0),
        'p_sample': nrm((DEPTH, DEC_BATCH, DEC_SEQ, PLE_DIM), 1.0),
        'cache_k_a': nrm((DEPTH, DEC_BATCH, rows, N_HEADS_A, HEAD_DIM), 1.0),
        'cache_v_a': nrm((DEPTH, DEC_BATCH, rows, N_HEADS_A, HEAD_DIM), 1.0),
        'state_ret': nrm((DEPTH, DEC_BATCH, N_HEADS_B, HEAD_DIM, HEAD_DIM), 0.5),
        'state_conv': nrm((DEPTH, DEC_BATCH, CONV_W - 1, W_C), 1.0),
        'state_lru': nrm((DEPTH, DEC_BATCH, W_C), 0.5),
        'w_in': nrm((DEPTH, D_MODEL, N_IN), D_MODEL ** -0.5),
        'rel_table': nrm((DEPTH, N_HEADS_A, 2 * REL_CLIP + 1), 0.5),
        'gn_gain': 1.0 + nrm((DEPTH, W_B), 0.1),
        'conv_w': nrm((DEPTH, CONV_W, W_C), CONV_W ** -0.5),
        'conv_b': nrm((DEPTH, W_C), 0.02),
        'w_gate_a': nrm((DEPTH, N_BLOCKS_C, BLOCK_C, BLOCK_C), BLOCK_C ** -0.5),
        'b_gate_a': nrm((DEPTH, W_C), 0.02),
        'w_gate_x': nrm((DEPTH, N_BLOCKS_C, BLOCK_C, BLOCK_C), BLOCK_C ** -0.5),
        'b_gate_x': nrm((DEPTH, W_C), 0.02),
        'lru_lambda': jnp.log(sig) - jnp.log1p(-sig),
        'w_branch': nrm((DEPTH, N_BRANCH, W_A, D_MODEL), (W_A ** -0.5) * BETA),
        'w_out': nrm((DEPTH, D_MODEL, D_MODEL), (D_MODEL ** -0.5) * BETA),
        'ln_gain': 1.0 + nrm((DEPTH, D_MODEL), 0.05),
        'ln_bias': nrm((DEPTH, D_MODEL), 0.02),
        'w_ple': nrm((DEPTH, PLE_DIM, D_MODEL), PLE_DIM ** -0.5),
        'w_ple_gate': nrm((DEPTH, D_MODEL, D_MODEL), D_MODEL ** -0.5),
    }


def reference(x_prompt, x_sample, p_prompt, p_sample, cache_k_a, cache_v_a, state_ret, state_conv,
              state_lru, w_in, rel_table, gn_gain, conv_w, conv_b, w_gate_a, b_gate_a, w_gate_x,
              b_gate_x, lru_lambda, w_branch, w_out, ln_gain, ln_bias, w_ple, w_ple_gate):
    bp, tp = x_prompt.shape[0], x_prompt.shape[1]
    ts = x_sample.shape[1]
    dt = x_prompt.dtype
    pos_p = jnp.arange(tp)
    pos_s = PAST_LEN + jnp.arange(ts)
    hp, hs = x_prompt, x_sample
    kp_l, vp_l, rp_l, cp_l, lp_l = [], [], [], [], []
    ks_l, vs_l, rs_l, cs_l, ls_l = [], [], [], [], []
    for l in range(DEPTH):
        wl = (w_in[l], rel_table[l], gn_gain[l], conv_w[l], conv_b[l], w_gate_a[l], b_gate_a[l],
              w_gate_x[l], b_gate_x[l], lru_lambda[l], w_branch[l], w_out[l], ln_gain[l], ln_bias[l],
              w_ple[l], w_ple_gate[l])
        hp, (k_p, v_p, r_p, c_p, s_p) = layer(
            hp, p_prompt[l], pos_p, *wl, None, None,
            jnp.zeros((bp, N_HEADS_B, HEAD_DIM, HEAD_DIM), dt),
            jnp.zeros((bp, CONV_W - 1, W_C), dt),
            jnp.zeros((bp, W_C), dt))
        hs, (k_s, v_s, r_s, c_s, s_s) = layer(
            hs, p_sample[l], pos_s, *wl, cache_k_a[l], cache_v_a[l],
            state_ret[l], state_conv[l], state_lru[l])
        kp_l.append(k_p); vp_l.append(v_p); rp_l.append(r_p); cp_l.append(c_p); lp_l.append(s_p)
        ks_l.append(k_s); vs_l.append(v_s); rs_l.append(r_s); cs_l.append(c_s); ls_l.append(s_s)
    return (hp, hs,
            jnp.stack(kp_l), jnp.stack(vp_l), jnp.stack(ks_l), jnp.stack(vs_l),
            jnp.stack(rp_l), jnp.stack(rs_l), jnp.stack(cp_l), jnp.stack(cs_l),
            jnp.stack(lp_l), jnp.stack(ls_l))
```

```cpp
#include <hip/hip_runtime.h>
#include <hip/hip_cooperative_groups.h>
#include <cstdio>
namespace cg = cooperative_groups;

#define DI __device__ __forceinline__
#define LAS __attribute__((address_space(3)))
typedef unsigned short bf16_t;
typedef short bf16x8 __attribute__((ext_vector_type(8)));
typedef short s16x4 __attribute__((ext_vector_type(4)));
typedef float f32x4 __attribute__((ext_vector_type(4)));
typedef unsigned u32x2 __attribute__((ext_vector_type(2)));

constexpr int DM = 1024, NIN = 8192, PROWS = 65536, SROWS = 512, NGROUP = 3, RG = 32768, NSLOT_P = 16;
constexpr float ALPHA_C = 1.4142135623730951f;
constexpr float NEGINF = -1e30f;
constexpr size_t O_YP = 0, O_YS = 67108864, O_KP = 67633152, O_VP = 84410368, O_KS = 101187584, O_VS = 101711872,
                 O_RP = 102236160, O_RS = 104333312, O_CP = 105381888, O_CS = 105480192, O_LP = 105529344, O_LS = 105562112;
constexpr size_t MiB = 1048576;
constexpr size_t W_WIN = 0;
constexpr size_t W_WBR = W_WIN + 32 * MiB;
constexpr size_t W_WOUT = W_WBR + 6 * MiB;
constexpr size_t W_WPG = W_WOUT + 4 * MiB;
constexpr size_t W_WPE = W_WPG + 4 * MiB;
constexpr size_t W_WG = W_WPE + 1 * MiB;
constexpr size_t W_ROPE = W_WG + 1 * MiB;
constexpr size_t W_SK = W_ROPE + 1 * MiB;
constexpr size_t W_SVT = W_SK + 19 * MiB;
constexpr size_t W_XB = W_SVT + 19 * MiB;
constexpr size_t W_PB = W_XB + 64 * MiB;
constexpr size_t W_U = W_PB + 32 * MiB;
constexpr size_t U_QA = W_U, U_KA = W_U + 32 * MiB, U_ZA = W_U + 64 * MiB, U_QB = W_U + 96 * MiB, U_KB = W_U + 128 * MiB, U_ZB = W_U + 160 * MiB,
                 U_XR = W_U + 192 * MiB, U_ZC = W_U + 224 * MiB, U_GS = W_U + 256 * MiB;
constexpr size_t W_VTA = W_U + 448 * MiB;
constexpr size_t W_KTB = W_VTA + 32 * MiB;
constexpr size_t W_VTB = W_KTB + 32 * MiB;
constexpr size_t W_KV = W_VTB + 32 * MiB;
constexpr size_t W_SP = W_KV + 64 * MiB;
constexpr size_t W_LH = W_SP + 32 * MiB;
constexpr size_t W_LPR = W_LH + 32 * MiB;
constexpr size_t W_PAGG = W_LPR + 32 * MiB;
constexpr size_t W_HAGG = W_PAGG + 4 * MiB;
constexpr size_t W_CARRY = W_HAGG + 4 * MiB;
constexpr size_t W_Y = W_CARRY + 4 * MiB;
constexpr size_t W_BAR = W_Y + 96 * MiB;
constexpr size_t W_END = W_BAR + 1 * MiB;
constexpr size_t W_MB = U_QA;
constexpr size_t W_RB = U_ZA;
constexpr size_t W_RF = U_KB;
constexpr size_t W_PE = U_XR;
static_assert(W_END <= 1024 * MiB, "workspace layout exceeds 1 GiB");

struct Params {
    const float* in[25];
    float* out;
    unsigned char* ws;
    int ph_lo, ph_hi;
};

typedef __bf16 bf16x2_t __attribute__((ext_vector_type(2)));
typedef float f32x2_t __attribute__((ext_vector_type(2)));
DI unsigned pk2(float lo, float hi) { f32x2_t f = {lo, hi}; bf16x2_t b = __builtin_convertvector(f, bf16x2_t); return __builtin_bit_cast(unsigned, b); }
DI bf16_t f2bf(float f) { return (bf16_t)(pk2(f, 0.f) & 0xffffu); }
DI float bf2f(unsigned short x) { return __uint_as_float(((unsigned)x) << 16); }
DI void st_bf4(bf16_t* p, f32x4 v) { u32x2 w; w.x = pk2(v.x, v.y); w.y = pk2(v.z, v.w); *(u32x2*)p = w; }
DI f32x4 ld_bf4(const bf16_t* p) { u32x2 w = *(const u32x2*)p; f32x4 v; v.x = __uint_as_float(w.x << 16); v.y = __uint_as_float(w.x & 0xffff0000u);
    v.z = __uint_as_float(w.y << 16); v.w = __uint_as_float(w.y & 0xffff0000u); return v; }
DI f32x4 bf4_to_f(u32x2 w) { f32x4 v; v.x = __uint_as_float(w.x << 16); v.y = __uint_as_float(w.x & 0xffff0000u); v.z = __uint_as_float(w.y << 16); v.w = __uint_as_float(w.y & 0xffff0000u); return v; }
DI bf16x8 ld8(const bf16_t* p) { return *(const bf16x8*)p; }
DI bf16x8 ld4x2(const bf16_t* p0, const bf16_t* p1) { s16x4 a = *(const s16x4*)p0, b = *(const s16x4*)p1; return __builtin_shufflevector(a, b, 0, 1, 2, 3, 4, 5, 6, 7); }
DI bf16x8 pack8(f32x4 a, f32x4 b) { typedef unsigned u32x4 __attribute__((ext_vector_type(4))); u32x4 w; w.x = pk2(a.x, a.y); w.y = pk2(a.z, a.w); w.z = pk2(b.x, b.y); w.w = pk2(b.z, b.w); return __builtin_bit_cast(bf16x8, w); }
DI float sigm(float x) { return __builtin_amdgcn_rcpf(1.0f + __expf(-x)); }
DI float sigm_d(float x) { return 1.0f / (1.0f + __expf(-x)); }
DI float lg2gamma(int h) { float x = __uint_as_float((unsigned)(127 - 5 - h) << 23); return -(x + x * x * 0.5f + x * x * x * (1.f / 3.f) + x * x * x * x * 0.25f + x * x * x * x * x * 0.2f) * 1.4426950408889634f; }
DI int tid_l() { int t = threadIdx.x; asm volatile("" : "+v"(t)); return t; }
DI int bid_l() { int b = blockIdx.x; asm volatile("" : "+s"(b)); return b; }
DI float shx(float v, int lane, int m) { return __int_as_float(__builtin_amdgcn_ds_bpermute((lane ^ m) << 2, __float_as_int(v))); }
DI float shup16(float v, int lane, int d) { return __int_as_float(__builtin_amdgcn_ds_bpermute((((lane & 15) >= d) ? lane - d : lane) << 2, __float_as_int(v))); }
#define MFMA16(a, b, c) __builtin_amdgcn_mfma_f32_16x16x32_bf16((a), (b), (c), 0, 0, 0)

namespace pg8 {
constexpr int BM = 256, BK = 64, HALF = 128, HTB = HALF * BK * 2, STAGE_BYTES = 8 * HTB, NXCD = 8, WGM = 8;
DI int lds_byte(int r, int c) { const int st = (r >> 4) * 2 + (c >> 5), rr = r & 15, cc = c & 31, ob = rr * 64 + cc * 2; return st * 1024 + (ob ^ (((ob >> 9) & 1) << 5)); }
DI void stage_rc(int b, int& R, int& C) { const int st = b / 1024, sb = b % 1024, swz = sb ^ (((sb >> 9) & 1) << 5); R = (st >> 1) * 16 + swz / 64; C = (st & 1) * 32 + (swz % 64) / 2; }
struct Unit { int pm, pn; };
struct Gemm { const bf16_t* A; const bf16_t* Bt; int M, N, K; };
struct StaticOrder {
    int nM, nN, nwg, G, c;
    DI void init(int M, int N, int G_, int c_) { nM = M / BM; nN = N / BM; nwg = nM * nN; G = G_; c = c_; }
    DI bool next(int i, Unit& u) const {
        const long L = (long)i * G + c; if (L >= nwg) return false;
        int wgid = (int)L; { const int q = nwg / NXCD, r = nwg % NXCD, xcd = wgid % NXCD, off = wgid / NXCD; wgid = (xcd < r ? xcd * (q + 1) : r * (q + 1) + (xcd - r) * q) + off; }
        const int nig = WGM * nN, gid = wgid / nig, fm = gid * WGM, gsz = (nM - fm) < WGM ? (nM - fm) : WGM;
        u.pm = fm + ((wgid % nig) % gsz); u.pn = (wgid % nig) / gsz; return true;
    }
};
template <class Epi>
DI void gemm_phase(LAS unsigned char* lds, const Gemm g, const StaticOrder& S, const Epi& E) {
    const int tid = tid_l(), wid = __builtin_amdgcn_readfirstlane(tid >> 6), lane = tid & 63, wr = wid >> 2, wc = wid & 3, fr = lane & 15, fq = lane >> 4;
    const int K = g.K, nt = K / BK;
    unsigned voffA[2];
#pragma unroll
    for (int i = 0; i < 2; ++i) { int R, C; stage_rc(tid * 16 + i * 8192, R, C); voffA[i] = (unsigned)(R * K + C) * 2u; }
    const size_t kstep = (size_t)(BK * 2);
    const size_t hstep = (size_t)HALF * K * 2;
    const size_t tstep = 2 * hstep;
    const unsigned ldsw = (unsigned)wid * 1024u;
    const int aoff = lds_byte(wr * 64 + fr, fq * 8), boff = lds_byte(wc * 32 + fr, fq * 8);
#define PG8_SA(b, h) (((b) * 2 + (h)) * HTB)
#define PG8_SB(b, h) ((4 + (b) * 2 + (h)) * HTB)
#define PG8_STAGE(bufoff, gbase) do { _Pragma("unroll") for (int _i = 0; _i < 2; ++_i) \
        __builtin_amdgcn_global_load_lds((const unsigned*)((const char*)(gbase) + voffA[_i]), (LAS unsigned*)(lds + (bufoff) + ldsw + _i * 8192), 16, 0, 0); } while (0)
#define PG8_LDA(dst, b, h) do { _Pragma("unroll") for (int m = 0; m < 4; ++m) _Pragma("unroll") for (int k = 0; k < 2; ++k) dst[m][k] = *(const LAS bf16x8*)(lds + PG8_SA(b, h) + aoff + m * 2048 + k * 1024); } while (0)
#define PG8_LDB(dst, b, h) do { _Pragma("unroll") for (int n = 0; n < 2; ++n) _Pragma("unroll") for (int k = 0; k < 2; ++k) dst[n][k] = *(const LAS bf16x8*)(lds + PG8_SB(b, h) + boff + n * 2048 + k * 1024); } while (0)
#define PG8_MMA(ai, bj, At, Bt) do { __builtin_amdgcn_s_setprio(1); _Pragma("unroll") for (int m = 0; m < 4; ++m) _Pragma("unroll") for (int n = 0; n < 2; ++n) _Pragma("unroll") for (int k = 0; k < 2; ++k) \
        acc[ai][bj][m][n] = __builtin_amdgcn_mfma_f32_16x16x32_bf16(Bt[n][k], At[m][k], acc[ai][bj][m][n], 0, 0, 0); __builtin_amdgcn_s_setprio(0); } while (0)
#define PG8_WAIT_V(n) asm volatile("s_waitcnt vmcnt(" #n ")" ::: "memory")
#define PG8_WAIT_L(n) asm volatile("s_waitcnt lgkmcnt(" #n ")" ::: "memory")
#define PG8_BAR __builtin_amdgcn_s_barrier()
#define PG8_SCHED __builtin_amdgcn_sched_barrier(0)
    Unit cur, nxt; int ui = 0;
    if (!S.next(0, cur)) return;
    f32x4 acc[2][2][4][2];
#pragma unroll
    for (int a = 0; a < 2; ++a)
#pragma unroll
        for (int b = 0; b < 2; ++b)
#pragma unroll
            for (int m = 0; m < 4; ++m)
#pragma unroll
                for (int n = 0; n < 2; ++n) acc[a][b][m][n] = (f32x4){0.f, 0.f, 0.f, 0.f};
    bf16x8 At[4][2], B0[2][2], B1[2][2];
    const char* cA = (const char*)g.A + (size_t)cur.pm * tstep; const char* cB = (const char*)g.Bt + (size_t)cur.pn * tstep;
    PG8_STAGE(PG8_SB(0, 0), cB); PG8_STAGE(PG8_SA(0, 0), cA); PG8_STAGE(PG8_SB(0, 1), cB + hstep); PG8_STAGE(PG8_SA(0, 1), cA + hstep);
    if (wr == 1) PG8_BAR;
    PG8_WAIT_V(4); PG8_BAR;
    PG8_STAGE(PG8_SB(1, 0), cB + kstep); PG8_STAGE(PG8_SA(1, 0), cA + kstep); PG8_STAGE(PG8_SB(1, 1), cB + hstep + kstep);
    PG8_WAIT_V(6); PG8_BAR;
    for (;;) {
        const bool has_next = S.next(ui + 1, nxt);
        const char* nA = has_next ? (const char*)g.A + (size_t)nxt.pm * tstep : cA; const char* nB = has_next ? (const char*)g.Bt + (size_t)nxt.pn * tstep : cB;
        for (int t = 0; t < nt; t += 2) {
            const bool last = (t == nt - 2);
            const char* a1 = cA + (size_t)(t + 1) * kstep;
            const char* a2 = last ? nA : cA + (size_t)(t + 2) * kstep; const char* b2 = last ? nB : cB + (size_t)(t + 2) * kstep;
            const char* a3 = a2 + kstep; const char* b3 = b2 + kstep;
            if constexpr (Epi::HAS_MID) { if (t == 8 || t == 16) { E.mid(acc, cur, t, wr, wc, fr, fq); PG8_SCHED; } }
            PG8_LDB(B0, 0, 0); PG8_SCHED; PG8_LDA(At, 0, 0); PG8_STAGE(PG8_SA(1, 1), a1 + hstep);
            PG8_WAIT_L(8); PG8_BAR; PG8_WAIT_L(0); PG8_MMA(0, 0, At, B0); PG8_BAR; PG8_SCHED;
            PG8_LDB(B1, 0, 1); PG8_STAGE(PG8_SB(0, 0), b2);
            PG8_BAR; PG8_WAIT_L(0); PG8_MMA(0, 1, At, B1); PG8_BAR;
            PG8_LDA(At, 0, 1); PG8_STAGE(PG8_SA(0, 0), a2);
            PG8_BAR; PG8_WAIT_L(0); PG8_MMA(1, 0, At, B0); PG8_BAR; PG8_SCHED;
            PG8_STAGE(PG8_SB(0, 1), b2 + hstep);
            PG8_WAIT_V(6); PG8_BAR; PG8_MMA(1, 1, At, B1); PG8_BAR;
            PG8_LDB(B0, 1, 0); PG8_SCHED; PG8_LDA(At, 1, 0); PG8_STAGE(PG8_SA(0, 1), a2 + hstep);
            PG8_WAIT_L(8); PG8_BAR; PG8_WAIT_L(0); PG8_MMA(0, 0, At, B0); PG8_BAR; PG8_SCHED;
            PG8_LDB(B1, 1, 1); PG8_STAGE(PG8_SB(1, 0), b3);
            PG8_BAR; PG8_WAIT_L(0); PG8_MMA(0, 1, At, B1); PG8_BAR;
            PG8_LDA(At, 1, 1); PG8_STAGE(PG8_SA(1, 0), a3);
            PG8_BAR; PG8_WAIT_L(0); PG8_MMA(1, 0, At, B0); PG8_BAR; PG8_SCHED;
            PG8_STAGE(PG8_SB(1, 1), b3 + hstep);
            PG8_WAIT_V(6); PG8_BAR; PG8_MMA(1, 1, At, B1); PG8_BAR;
        }
        E(acc, cur, wr, wc, fr, fq);
        if (!has_next) break;
#pragma unroll
        for (int a = 0; a < 2; ++a)
#pragma unroll
            for (int b = 0; b < 2; ++b)
#pragma unroll
                for (int m = 0; m < 4; ++m)
#pragma unroll
                    for (int n = 0; n < 2; ++n) acc[a][b][m][n] = (f32x4){0.f, 0.f, 0.f, 0.f};
        cur = nxt; cA = nA; cB = nB; ++ui;
    }
    PG8_WAIT_V(0);
    if (wr == 0) PG8_BAR;
    PG8_BAR;
#undef PG8_SA
#undef PG8_SB
#undef PG8_STAGE
#undef PG8_LDA
#undef PG8_LDB
#undef PG8_MMA
#undef PG8_WAIT_V
#undef PG8_WAIT_L
#undef PG8_BAR
#undef PG8_SCHED
}
}
using pg8::Unit;

template <int MB, class LF, class BF>
DI void epi_ai_loop2(const Unit& u, int wr, int wc, int fr, int fq, LF&& loads, BF&& body) {
#pragma unroll
    for (int ai = 0; ai < 2; ++ai)
#pragma unroll
      for (int m0 = 0; m0 < 4; m0 += MB) {
#pragma unroll
        for (int m = m0; m < m0 + MB; ++m)
#pragma unroll
            for (int bj = 0; bj < 2; ++bj)
#pragma unroll
                for (int n = 0; n < 2; ++n) loads(ai, m, bj, n, u.pm * 256 + ai * 128 + wr * 64 + m * 16 + fr, u.pn * 256 + bj * 128 + wc * 32 + n * 16 + 4 * fq);
        __builtin_amdgcn_sched_barrier(0);
#pragma unroll
        for (int m = m0; m < m0 + MB; ++m)
#pragma unroll
            for (int bj = 0; bj < 2; ++bj)
#pragma unroll
                for (int n = 0; n < 2; ++n) body(ai, m, bj, n, u.pm * 256 + ai * 128 + wr * 64 + m * 16 + fr, u.pn * 256 + bj * 128 + wc * 32 + n * 16 + 4 * fq);
        __builtin_amdgcn_sched_barrier(0);
      }
}
struct EpiIn {
    static constexpr bool HAS_MID = false;
    unsigned char* ws; bf16_t *SK, *SVT; float *outK, *outV, *outConv; const float* rope; int sample, seq0, T, blk, nch;
    template <int R> DI void body(const f32x4 (&acc)[2][2][4][2], const Unit& u, int wr, int wc, int fr, int fq) const {
        const int colt = u.pn * 256;
        bf16_t* const QA = (bf16_t*)(ws + U_QA); bf16_t* const KA = (bf16_t*)(ws + U_KA); bf16_t* const ZA = (bf16_t*)(ws + U_ZA);
        bf16_t* const QB = (bf16_t*)(ws + U_QB); bf16_t* const KB = (bf16_t*)(ws + U_KB); bf16_t* const ZB = (bf16_t*)(ws + U_ZB);
        bf16_t* const XR = (bf16_t*)(ws + U_XR); bf16_t* const ZC = (bf16_t*)(ws + U_ZC); bf16_t* const GS = (bf16_t*)(ws + U_GS);
        bf16_t* const TVA = (bf16_t*)(ws + W_VTA); bf16_t* const TKB = (bf16_t*)(ws + W_KTB); bf16_t* const TVB = (bf16_t*)(ws + W_VTB);
#pragma unroll
        for (int ai = 0; ai < 2; ++ai)
#pragma unroll
            for (int m = 0; m < 4; ++m) {
                int frx = fr; asm volatile("" : "+v"(frx));
                const int lrow = u.pm * 256 + ai * 128 + wr * 64 + m * 16 + frx;
                int slot, t, pos;
                if (sample) { slot = lrow >> 5; t = lrow & 31; pos = 1024 + t; } else { slot = lrow >> 11; t = lrow & 2047; pos = t; }
#pragma unroll
                for (int bj = 0; bj < 2; ++bj)
#pragma unroll
                    for (int n = 0; n < 2; ++n) {
                        const int col = colt + bj * 128 + wc * 32 + n * 16 + 4 * fq;
                        const int c = col & 511, h = c >> 6, d = c & 63;
                        const size_t hm = (((size_t)slot * 8 + h) * T + t) * 64 + d;
                        const size_t tm = (((size_t)slot * 8 + h) * nch + (sample ? 0 : (t >> 6))) * (size_t)(64 * blk) + (size_t)d * blk + (t & (blk - 1));
                        f32x4 v = acc[ai][bj][m][n];
                        if constexpr (R == 0) { st_bf4(QA + hm, v * (0.125f * 1.4426950408889634f)); }
                        else if constexpr (R == 1) {
                            if (sample) { st_bf4(SK + ((size_t)(slot * 576 + 512 + t)) * 512 + c, v); *(f32x4*)(outK + (size_t)(slot * 32 + t) * 512 + c) = v; }
                            else { st_bf4(KA + hm, v); if (t >= 1536) *(f32x4*)(outK + ((size_t)(seq0 + slot) * 512 + (t - 1536)) * 512 + c) = v; }
                        } else if constexpr (R == 2) {
                            if (sample) { bf16_t* dd = SVT + ((size_t)(slot * 512 + c)) * 576 + 512 + t; dd[0] = f2bf(v.x); dd[576] = f2bf(v.y); dd[2 * 576] = f2bf(v.z); dd[3 * 576] = f2bf(v.w);
                                *(f32x4*)(outV + (size_t)(slot * 32 + t) * 512 + c) = v; }
                            else { bf16_t* dd = TVA + tm; dd[0] = f2bf(v.x); dd[64] = f2bf(v.y); dd[128] = f2bf(v.z); dd[192] = f2bf(v.w);
                                if (t >= 1536) *(f32x4*)(outV + ((size_t)(seq0 + slot) * 512 + (t - 1536)) * 512 + c) = v; }
                        } else if constexpr (R == 3 || R == 7 || R == 9) {
                            f32x4 o; o.x = v.x * sigm(v.x); o.y = v.y * sigm(v.y); o.z = v.z * sigm(v.z); o.w = v.w * sigm(v.w);
                            if constexpr (R == 3) st_bf4(ZA + hm, o); else if constexpr (R == 7) st_bf4(ZB + hm, o); else st_bf4(ZC + (size_t)lrow * 512 + c, o);
                        } else if constexpr (R == 4 || R == 5) {
                            const int i0 = d >> 1;
                            const float c0 = rope[pos * 32 + i0], c1 = rope[pos * 32 + i0 + 1], s0 = rope[65536 + pos * 32 + i0], s1 = rope[65536 + pos * 32 + i0 + 1];
                            float o1a = v.x * c0 - v.y * s0, o2a = v.x * s0 + v.y * c0, o1b = v.z * c1 - v.w * s1, o2b = v.z * s1 + v.w * c1;
                            if constexpr (R == 5) { o1a *= 0.125f; o2a *= 0.125f; o1b *= 0.125f; o2b *= 0.125f; }
                            bf16_t* dst = (R == 4 ? QB : KB) + (hm - d);
                            *(unsigned*)(dst + i0) = pk2(o1a, o1b); *(unsigned*)(dst + 32 + i0) = pk2(o2a, o2b);
                            if constexpr (R == 5) {
                                const float zeta = exp2f(lg2gamma(h) * (float)(blk - 1 - (t & (blk - 1))));
                                bf16_t* dd = TKB + (tm - (size_t)d * blk) + (size_t)i0 * blk;
                                dd[0] = f2bf(o1a * zeta); dd[blk] = f2bf(o1b * zeta); dd[(size_t)32 * blk] = f2bf(o2a * zeta); dd[(size_t)33 * blk] = f2bf(o2b * zeta);
                            }
                        } else if constexpr (R == 6) {
                            bf16_t* dd = TVB + tm; dd[0] = f2bf(v.x); dd[blk] = f2bf(v.y); dd[2 * blk] = f2bf(v.z); dd[3 * blk] = f2bf(v.w);
                        } else if constexpr (R == 8) {
                            st_bf4(XR + (size_t)lrow * 512 + c, v);
                            if (sample) { if (t >= 29) *(f32x4*)(outConv + (size_t)(slot * 3 + t - 29) * 512 + c) = v; }
                            else { if (t >= 2045) *(f32x4*)(outConv + (size_t)((seq0 + slot) * 3 + t - 2045) * 512 + c) = v; }
                        } else {
                            f32x4 o; o.x = sigm(v.x); o.y = sigm(v.y); o.z = sigm(v.z); o.w = sigm(v.w);
                            const int cg = col - 5120, b = cg >> 10, pn4 = (cg >> 8) & 3;
                            st_bf4(GS + ((((size_t)b * (RG / 256) + u.pm) * 4 + pn4) << 16) + (size_t)(lrow & 255) * 256 + (cg & 255), o);
                        }
                    }
                __builtin_amdgcn_sched_barrier(0);
            }
    }
    template <int R> DI void body_rope(const f32x4 (&acc)[2][2][4][2], const Unit& u, int wr, int wc, int fr, int fq) const {
        bf16_t* const QB = (bf16_t*)(ws + U_QB); bf16_t* const KB = (bf16_t*)(ws + U_KB); bf16_t* const TKB = (bf16_t*)(ws + W_KTB);
        f32x2_t cv[4][2][2], sv[4][2][2];
        epi_ai_loop2<4>(u, wr, wc, fr, fq,
            [&](int ai, int m, int bj, int n, int lrow, int col) { const int t = sample ? (lrow & 31) : (lrow & 2047), pos = sample ? 1024 + t : t, i0 = (col & 63) >> 1;
                cv[m][bj][n] = *(const f32x2_t*)(rope + pos * 32 + i0); sv[m][bj][n] = *(const f32x2_t*)(rope + 65536 + pos * 32 + i0); },
            [&](int ai, int m, int bj, int n, int lrow, int col) {
                int slot, t; if (sample) { slot = lrow >> 5; t = lrow & 31; } else { slot = lrow >> 11; t = lrow & 2047; }
                const int c = col & 511, h = c >> 6, d = c & 63, i0 = d >> 1;
                const size_t hm = (((size_t)slot * 8 + h) * T + t) * 64;
                const f32x4 v = acc[ai][bj][m][n]; const float c0 = cv[m][bj][n].x, c1 = cv[m][bj][n].y, s0 = sv[m][bj][n].x, s1 = sv[m][bj][n].y;
                float o1a = v.x * c0 - v.y * s0, o2a = v.x * s0 + v.y * c0, o1b = v.z * c1 - v.w * s1, o2b = v.z * s1 + v.w * c1;
                if constexpr (R == 5) { o1a *= 0.125f; o2a *= 0.125f; o1b *= 0.125f; o2b *= 0.125f; }
                bf16_t* dst = (R == 4 ? QB : KB) + hm;
                *(unsigned*)(dst + i0) = pk2(o1a, o1b); *(unsigned*)(dst + 32 + i0) = pk2(o2a, o2b);
                if constexpr (R == 5) {
                    const float zeta = exp2f(lg2gamma(h) * (float)(blk - 1 - (t & (blk - 1))));
                    bf16_t* dd = TKB + (((size_t)slot * 8 + h) * nch + (sample ? 0 : (t >> 6))) * (size_t)(64 * blk) + (size_t)i0 * blk + (t & (blk - 1));
                    dd[0] = f2bf(o1a * zeta); dd[blk] = f2bf(o1b * zeta); dd[(size_t)32 * blk] = f2bf(o2a * zeta); dd[(size_t)33 * blk] = f2bf(o2b * zeta);
                } });
    }
    DI void operator()(const f32x4 (&acc)[2][2][4][2], const Unit& u, int wr, int wc, int fr, int fq) const {
        const int region = (u.pn * 256) >> 9;
        switch (region) {
            case 0: body<0>(acc, u, wr, wc, fr, fq); break;
            case 1: body<1>(acc, u, wr, wc, fr, fq); break;
            case 2: body<2>(acc, u, wr, wc, fr, fq); break;
            case 3: body<3>(acc, u, wr, wc, fr, fq); break;
            case 7: body<7>(acc, u, wr, wc, fr, fq); break;
            case 9: body<9>(acc, u, wr, wc, fr, fq); break;
            case 4: body_rope<4>(acc, u, wr, wc, fr, fq); break;
            case 5: body_rope<5>(acc, u, wr, wc, fr, fq); break;
            case 6: body<6>(acc, u, wr, wc, fr, fq); break;
            case 8: body<8>(acc, u, wr, wc, fr, fq); break;
            default: body<10>(acc, u, wr, wc, fr, fq); break;
        }
    }
};
#define EPI_LOOP(...) \
    _Pragma("unroll") for (int ai = 0; ai < 2; ++ai) _Pragma("unroll") for (int m = 0; m < 4; ++m) { \
        const int lrow = u.pm * 256 + ai * 128 + wr * 64 + m * 16 + fr; \
        _Pragma("unroll") for (int bj = 0; bj < 2; ++bj) _Pragma("unroll") for (int n = 0; n < 2; ++n) { \
            const int col = u.pn * 256 + bj * 128 + wc * 32 + n * 16 + 4 * fq; __VA_ARGS__ } __builtin_amdgcn_sched_barrier(0); }
struct EpiPE { static constexpr bool HAS_MID = false; bf16_t* PE;
    DI void operator()(const f32x4 (&acc)[2][2][4][2], const Unit& u, int wr, int wc, int fr, int fq) const {
        EPI_LOOP({ st_bf4(PE + (size_t)lrow * DM + col, acc[ai][bj][m][n]); }) } };
struct EpiMerge { static constexpr bool HAS_MID = true; const bf16_t* U; bf16_t* Mb;
    DI size_t goff(int lrow, int col, int b) const { return ((((size_t)b * (RG / 256) + (lrow >> 8)) * 4 + (col >> 8)) << 16) + (size_t)(lrow & 255) * 256 + (col & 255); }
    DI void mid(f32x4 (&acc)[2][2][4][2], const Unit& u, int t, int wr, int wc, int fr, int fq) const {
        const int b = (t >> 3) - 1;
        u32x2 g0[4][2][2], g1[4][2][2];
        epi_ai_loop2<4>(u, wr, wc, fr, fq, [&](int ai, int m, int bj, int n, int lrow, int col) { const size_t o = goff(lrow, col, b); g0[m][bj][n] = *(const u32x2*)(U + o); g1[m][bj][n] = *(const u32x2*)(U + o + (size_t)(RG / 256) * 4 * 65536); }, [&](int ai, int m, int bj, int n, int lrow, int col) { const f32x4 a0 = bf4_to_f(g0[m][bj][n]), a1 = bf4_to_f(g1[m][bj][n]); f32x4 a = acc[ai][bj][m][n];
                       a.x *= fmaxf(a0.x, 1e-20f) * __builtin_amdgcn_rcpf(fmaxf(a1.x, 1e-20f)); a.y *= fmaxf(a0.y, 1e-20f) * __builtin_amdgcn_rcpf(fmaxf(a1.y, 1e-20f));
                       a.z *= fmaxf(a0.z, 1e-20f) * __builtin_amdgcn_rcpf(fmaxf(a1.z, 1e-20f)); a.w *= fmaxf(a0.w, 1e-20f) * __builtin_amdgcn_rcpf(fmaxf(a1.w, 1e-20f));
                       acc[ai][bj][m][n] = a; });
    }
    DI void operator()(const f32x4 (&acc)[2][2][4][2], const Unit& u, int wr, int wc, int fr, int fq) const {
        u32x2 g2[4][2][2];
        epi_ai_loop2<4>(u, wr, wc, fr, fq, [&](int ai, int m, int bj, int n, int lrow, int col) { g2[m][bj][n] = *(const u32x2*)(U + goff(lrow, col, 2)); }, [&](int ai, int m, int bj, int n, int lrow, int col) { f32x4 g = bf4_to_f(g2[m][bj][n]); g.x = fmaxf(g.x, 1e-20f); g.y = fmaxf(g.y, 1e-20f); g.z = fmaxf(g.z, 1e-20f); g.w = fmaxf(g.w, 1e-20f);
                       st_bf4(Mb + (size_t)lrow * DM + col, acc[ai][bj][m][n] * g); });
    } };
struct EpiOut { static constexpr bool HAS_MID = false; const bf16_t* xb; bf16_t* Rb;
    DI void operator()(const f32x4 (&acc)[2][2][4][2], const Unit& u, int wr, int wc, int fr, int fq) const {
        u32x2 xv[4][2][2];
        epi_ai_loop2<4>(u, wr, wc, fr, fq, [&](int ai, int m, int bj, int n, int lrow, int col) { xv[m][bj][n] = *(const u32x2*)(xb + (size_t)lrow * DM + col); },
            [&](int ai, int m, int bj, int n, int lrow, int col) { const f32x4 r = bf4_to_f(xv[m][bj][n]) * ALPHA_C + acc[ai][bj][m][n]; st_bf4(Rb + (size_t)lrow * DM + col, r); });
    } };
struct EpiGate { static constexpr bool HAS_MID = false; const bf16_t* PE; const bf16_t* Rb; bf16_t* R2;
    DI void operator()(const f32x4 (&acc)[2][2][4][2], const Unit& u, int wr, int wc, int fr, int fq) const {
        u32x2 rv[4][2][2], pv[4][2][2];
        epi_ai_loop2<4>(u, wr, wc, fr, fq, [&](int ai, int m, int bj, int n, int lrow, int col) { rv[m][bj][n] = *(const u32x2*)(Rb + (size_t)lrow * DM + col); pv[m][bj][n] = *(const u32x2*)(PE + (size_t)lrow * DM + col); },
            [&](int ai, int m, int bj, int n, int lrow, int col) { const f32x4 pe = bf4_to_f(pv[m][bj][n]); f32x4 r = bf4_to_f(rv[m][bj][n]); const f32x4 a = acc[ai][bj][m][n];
                       r.x += sigm(a.x) * pe.x; r.y += sigm(a.y) * pe.y; r.z += sigm(a.z) * pe.z; r.w += sigm(a.w) * pe.w; st_bf4(R2 + (size_t)lrow * DM + col, r); });
    } };

struct Grp { int gi, sample, rows, nslot, T, seq0; size_t grow0; };
DI Grp mkgrp(int gi) { Grp g; g.gi = gi; g.sample = (gi == NGROUP - 1); g.rows = g.sample ? SROWS : RG; g.nslot = 16; g.T = g.sample ? 32 : 2048; g.seq0 = gi * NSLOT_P; g.grow0 = (size_t)gi * RG; return g; }

DI void transpose_tile(const float* src, int srcN, bf16_t* dst, int dstStride, int k0, int n0, bool perm, float* tile) {
    const int tid = tid_l();
#pragma unroll
    for (int i = 0; i < 8; ++i) { const int kk = (tid >> 6) + 8 * i, nn = tid & 63; int nc = n0 + nn;
        if (perm) { const int hp = nc & 63; nc = (nc & ~63) + (hp >> 1) + 32 * (hp & 1); }
        tile[kk * 65 + nn] = src[(size_t)(k0 + kk) * srcN + nc]; }
    __syncthreads();
#pragma unroll
    for (int i = 0; i < 8; ++i) { const int nn = (tid >> 6) + 8 * i, kk = tid & 63; dst[(size_t)(n0 + nn) * dstStride + k0 + kk] = f2bf(tile[kk * 65 + nn]); }
}
DI void group_convert(const Params& p, int gi) {
    const Grp g = mkgrp(gi);
    bf16_t* xb = (bf16_t*)(p.ws + W_XB); bf16_t* pb = (bf16_t*)(p.ws + W_PB);
    const float* xs = g.sample ? p.in[1] : p.in[0] + g.grow0 * DM;
    const size_t gt = (size_t)bid_l() * 512 + tid_l(), gn = (size_t)gridDim.x * 512;
    const size_t nx = (size_t)g.rows * DM / 4;
    for (size_t i = gt; i < nx; i += gn) st_bf4(xb + i * 4, *(const f32x4*)(xs + i * 4));
    const size_t np = (size_t)g.rows * 256 / 4;
    for (int l = 0; l < 2; ++l) {
        const float* ps = g.sample ? p.in[3] + (size_t)l * SROWS * 256 : p.in[2] + ((size_t)l * PROWS + g.grow0) * 256;
        bf16_t* pd = pb + (size_t)l * RG * 256;
        for (size_t i = gt; i < np; i += gn) st_bf4(pd + i * 4, *(const f32x4*)(ps + i * 4));
    }
}
DI void phase_prep(const Params& p, float* tile) {
    bf16_t* WinT = (bf16_t*)(p.ws + W_WIN); bf16_t* WbrT = (bf16_t*)(p.ws + W_WBR); bf16_t* WoutT = (bf16_t*)(p.ws + W_WOUT);
    bf16_t* WpgT = (bf16_t*)(p.ws + W_WPG); bf16_t* WpeT = (bf16_t*)(p.ws + W_WPE); bf16_t* WgT = (bf16_t*)(p.ws + W_WG);
    bf16_t* SK = (bf16_t*)(p.ws + W_SK); bf16_t* SVT = (bf16_t*)(p.ws + W_SVT); float* rope = (float*)(p.ws + W_ROPE);
    constexpr int N0 = 4096, N1 = N0 + 768, N2 = N1 + 512, N3 = N2 + 512, N4 = N3 + 128, N5 = N4 + 32, N6 = N5 + 2048;
    float* const tile0 = tile; int par = 0;
    for (int it = bid_l(); it < N6; it += gridDim.x) {
        tile = tile0 + par * (64 * 65 + 15); par ^= 1;
        if (it < N0) { const int l = it >> 11, r = it & 2047, kt = r >> 7, ntl = r & 127; const int n0 = ntl * 64;
            transpose_tile(p.in[9] + (size_t)l * DM * NIN, NIN, WinT + (size_t)l * NIN * DM, DM, kt * 64, n0, n0 >= 2048 && n0 < 3072, tile);
        } else if (it < N1) { const int j = it - N0, lb = j >> 7, r = j & 127, kt = r >> 4, ntl = r & 15; const int l = lb / 3, b = lb % 3;
            transpose_tile(p.in[19] + (size_t)lb * 512 * DM, DM, WbrT + (size_t)l * DM * 1536 + b * 512, 1536, kt * 64, ntl * 64, false, tile);
        } else if (it < N2) { const int j = it - N1, l = j >> 8, r = j & 255;
            transpose_tile(p.in[20] + (size_t)l * DM * DM, DM, WoutT + (size_t)l * DM * DM, DM, (r >> 4) * 64, (r & 15) * 64, false, tile);
        } else if (it < N3) { const int j = it - N2, l = j >> 8, r = j & 255;
            transpose_tile(p.in[24] + (size_t)l * DM * DM, DM, WpgT + (size_t)l * DM * DM, DM, (r >> 4) * 64, (r & 15) * 64, false, tile);
        } else if (it < N4) { const int j = it - N3, l = j >> 6, r = j & 63;
            transpose_tile(p.in[23] + (size_t)l * 256 * DM, DM, WpeT + (size_t)l * DM * 256, 256, (r >> 4) * 64, (r & 15) * 64, false, tile);
        } else if (it < N5) { const int j = it - N4, l = j >> 4, which = (j >> 3) & 1, nb = j & 7;
            transpose_tile(p.in[which ? 16 : 14] + (size_t)(l * 8 + nb) * 4096, 64, WgT + (size_t)((l * 2 + which) * 8 + nb) * 4096, 64, 0, 0, false, tile);
        } else { const int j = it - N5, lb = j >> 6, r = j & 63;
            transpose_tile(p.in[5] + (size_t)lb * 512 * 512, 512, SVT + (size_t)lb * 512 * 576, 576, (r >> 3) * 64, (r & 7) * 64, false, tile);
        }
    }
    const size_t gt = (size_t)bid_l() * 512 + tid_l(), gn = (size_t)gridDim.x * 512;
    for (size_t i = gt; i < (size_t)32 * 576 * 128; i += gn) { const size_t lb = i / (576 * 128); const int rem = (int)(i % (576 * 128)), r = rem >> 7, c4 = (rem & 127) * 4;
        f32x4 v = {0.f, 0.f, 0.f, 0.f}; if (r < 512) v = *(const f32x4*)(p.in[4] + (lb * 512 + r) * 512 + c4);
        st_bf4(SK + (lb * 576 + r) * 512 + c4, v); }
    for (size_t i = gt; i < (size_t)32 * 512 * 16; i += gn) { const size_t row = i >> 4; const int c4 = (int)(i & 15) * 4; st_bf4(SVT + row * 576 + 512 + c4, (f32x4){0.f, 0.f, 0.f, 0.f}); }
    for (size_t i = gt; i < 65536; i += gn) { const int pos = (int)(i >> 5), k = (int)(i & 31);
        const float inv = exp2f(-(float)k * (13.287712379549449f / 32.0f)); const float ang = (float)pos * inv;
        const double rev = (double)ang * 0.15915494309189535; const float fr = (float)(rev - rint(rev));
        rope[i] = __builtin_amdgcn_cosf(fr); rope[65536 + i] = __builtin_amdgcn_sinf(fr); }
    { float* spl = rope + 131072;
      for (size_t i = gt; i < 1024; i += gn) { const float nl = -p.in[18][i]; spl[i] = -8.0f * (fmaxf(nl, 0.f) + log1pf(expf(-fabsf(nl)))); } }
    group_convert(p, 0);
}

constexpr int AT_ROWB = 144, AT_HEADB = 64 * AT_ROWB, AT_BUFB = 4 * AT_HEADB, AT_TAB = 2 * AT_BUFB;
template <int BLK, bool SAMPLE>
DI void attn_block(int item, const Params& p, int l, int tid, LAS unsigned char* lds) {
    constexpr int NCH = SAMPLE ? 1 : 32, T = SAMPLE ? 32 : 2048;
    const int wid = __builtin_amdgcn_readfirstlane(tid >> 6), lane = tid & 63, fr = lane & 15, fq = lane >> 4;
    const int hh = wid >> 2, w = wid & 3;
    const int hp = item & 3, c = (item >> 2) % NCH, slot = item / (4 * NCH);
    const int h = 2 * hp + hh;
    bf16_t* Y = (bf16_t*)(p.ws + W_Y);
    const size_t qrow = (size_t)slot * T + c * 64 + 16 * w + fr;
    const size_t qhm = (((size_t)slot * 8 + h) * T + c * 64 + 16 * w + fr) * 64;
    const bf16_t* QA = (const bf16_t*)(p.ws + U_QA); const bf16_t* ZA = (const bf16_t*)(p.ws + U_ZA);
    const int sh = tid >> 8, srow = (tid & 255) >> 2, scol = tid & 3;
    const bf16_t* Kg; const bf16_t* Vg; size_t ktile, vtile; int kr_base, o_start;
    if (SAMPLE) { Kg = (const bf16_t*)(p.ws + W_SK) + ((size_t)(l * 16 + slot) * 576 + srow) * 512 + (2 * hp + sh) * 64 + scol * 8; ktile = (size_t)64 * 512;
        Vg = (const bf16_t*)(p.ws + W_SVT) + ((size_t)(l * 16 + slot) * 512 + (2 * hp + sh) * 64 + srow) * 576 + scol * 8; vtile = 64; kr_base = 0; o_start = 0; }
    else { Kg = (const bf16_t*)(p.ws + U_KA) + (((size_t)slot * 8 + 2 * hp + sh) * 2048 + srow) * 64 + scol * 8; ktile = 4096;
        Vg = (const bf16_t*)(p.ws + W_VTA) + (((size_t)slot * 8 + 2 * hp + sh) * 32) * 4096 + srow * 64 + scol * 8; vtile = 4096; kr_base = c - 8; o_start = c < 8 ? 8 - c : 0; }
    const unsigned sdst = (unsigned)(sh * AT_HEADB + srow * AT_ROWB + scol * 16);
    LAS float* tl = (LAS float*)(lds + AT_TAB + wid * 2048);
    { const float* tab = p.in[10] + (size_t)(l * 8 + h) * 257;
      const float t0 = tab[lane], t1 = tab[lane + 64], t2 = tab[lane + 128], t3 = tab[lane + 192], t4 = tab[256];
      const float L2E = 1.4426950408889634f; tl[lane] = t0 * L2E; tl[lane + 64] = t1 * L2E; tl[lane + 128] = t2 * L2E; tl[lane + 192] = t3 * L2E; if (lane == 0) tl[256] = t4 * L2E; }
    bf16x8 qf[2];
    qf[0] = ld8(QA + qhm + 8 * fq); qf[1] = ld8(QA + qhm + 8 * fq + 32);
    u32x2 zg[4];
#pragma unroll
    for (int dt = 0; dt < 4; ++dt) zg[dt] = *(const u32x2*)(ZA + qhm + 16 * dt + 4 * fq);
    f32x4 oacc[4];
#pragma unroll
    for (int i = 0; i < 4; ++i) oacc[i] = (f32x4){0.f, 0.f, 0.f, 0.f};
    float mrun = NEGINF, lrun = 0.f;
    const int iq = 16 * w + fr;
    bf16x8 g0, g1, g2, g3;
    { const size_t tk = (size_t)(kr_base + o_start) * ktile, tv = (size_t)(kr_base + o_start) * vtile;
      g0 = ld8(Kg + tk); g1 = ld8(Kg + tk + 32); g2 = ld8(Vg + tv); g3 = ld8(Vg + tv + 32); }
    __syncthreads();
    *(LAS bf16x8*)(lds + sdst) = g0; *(LAS bf16x8*)(lds + sdst + 64) = g1; *(LAS bf16x8*)(lds + sdst + 2 * AT_HEADB) = g2; *(LAS bf16x8*)(lds + sdst + 2 * AT_HEADB + 64) = g3;
    __syncthreads();
    const float tab256 = tl[256];
    const unsigned kfo = (unsigned)(hh * AT_HEADB + fr * AT_ROWB + fq * 16), vfo = (unsigned)(2 * AT_HEADB + hh * AT_HEADB + fr * AT_ROWB + fq * 8);
    int buf = 0;
    for (int o = o_start; o < 9; ++o) {
        if (o < 8) { const size_t tk = (size_t)(kr_base + o + 1) * ktile, tv = (size_t)(kr_base + o + 1) * vtile;
            g0 = ld8(Kg + tk); g1 = ld8(Kg + tk + 32); g2 = ld8(Vg + tv); g3 = ld8(Vg + tv + 32); }
        LAS unsigned char* bb = lds + buf * AT_BUFB;
        f32x4 s[4];
#pragma unroll
        for (int mt = 0; mt < 4; ++mt) { const bf16x8 k0 = *(const LAS bf16x8*)(bb + kfo + mt * 16 * AT_ROWB), k1 = *(const LAS bf16x8*)(bb + kfo + mt * 16 * AT_ROWB + 64);
            f32x4 z = {0.f, 0.f, 0.f, 0.f}; z = MFMA16(k0, qf[0], z); s[mt] = MFMA16(k1, qf[1], z); }
        float tmax = NEGINF;
#pragma unroll
        for (int mt = 0; mt < 4; ++mt)
#pragma unroll
            for (int r = 0; r < 4; ++r) { const int jj = 16 * mt + 4 * fq + r; float b = tab256;
                if (o > 5) { int diff = 512 + iq - 64 * o - jj; diff = diff > 128 ? 128 : diff; b = tl[diff + 128]; }
                float v = s[mt][r] + b; if (SAMPLE && o == 8 && jj >= 32) v = NEGINF; s[mt][r] = v; tmax = fmaxf(tmax, v); }
        tmax = fmaxf(tmax, shx(tmax, lane, 16)); tmax = fmaxf(tmax, shx(tmax, lane, 32));
        const float mnew = fmaxf(mrun, tmax), alpha = __builtin_amdgcn_exp2f(mrun - mnew); mrun = mnew;
        float psum = 0.f;
#pragma unroll
        for (int mt = 0; mt < 4; ++mt)
#pragma unroll
            for (int r = 0; r < 4; ++r) { const float e = __builtin_amdgcn_exp2f(s[mt][r] - mnew); s[mt][r] = e; psum += e; }
        lrun = lrun * alpha + psum;
        const bf16x8 pb0 = pack8(s[0], s[1]), pb1 = pack8(s[2], s[3]);
#pragma unroll
        for (int dt = 0; dt < 4; ++dt) {
            const LAS unsigned char* vp = bb + vfo + dt * 16 * AT_ROWB;
            const s16x4 a0 = *(const LAS s16x4*)(vp), a1 = *(const LAS s16x4*)(vp + 32), a2 = *(const LAS s16x4*)(vp + 64), a3 = *(const LAS s16x4*)(vp + 96);
            f32x4 a = oacc[dt] * alpha; a = MFMA16(__builtin_shufflevector(a0, a1, 0, 1, 2, 3, 4, 5, 6, 7), pb0, a);
            oacc[dt] = MFMA16(__builtin_shufflevector(a2, a3, 0, 1, 2, 3, 4, 5, 6, 7), pb1, a); }
        if (o < 8) { LAS unsigned char* nb = lds + (buf ^ 1) * AT_BUFB;
            *(LAS bf16x8*)(nb + sdst) = g0; *(LAS bf16x8*)(nb + sdst + 64) = g1; *(LAS bf16x8*)(nb + sdst + 2 * AT_HEADB) = g2; *(LAS bf16x8*)(nb + sdst + 2 * AT_HEADB + 64) = g3; }
        __syncthreads();
        buf ^= 1;
    }
    lrun += shx(lrun, lane, 16); lrun += shx(lrun, lane, 32);
    const float inv = __builtin_amdgcn_rcpf(lrun);
    if (!SAMPLE || w < 2) {
#pragma unroll
        for (int dt = 0; dt < 4; ++dt) { const int col = h * 64 + 16 * dt + 4 * fq; const f32x4 g = bf4_to_f(zg[dt]); st_bf4(Y + qrow * 1536 + col, oacc[dt] * inv * g); }
    }
}

template <int BLK, bool SAMPLE>
DI void ret_chain(int chain, const Params& p, int l, int lane, float* retout) {
    constexpr int NCH = SAMPLE ? 1 : 32, KS = BLK / 32;
    const int fr = lane & 15, fq = lane >> 4;
    const int w = chain & 3, h = (chain >> 2) & 7, slot = chain >> 5;
    const bf16_t* KTB = (const bf16_t*)(p.ws + W_KTB); const bf16_t* VTB = (const bf16_t*)(p.ws + W_VTB); bf16_t* SP = (bf16_t*)(p.ws + W_SP);
    f32x4 S[4];
#pragma unroll
    for (int nt = 0; nt < 4; ++nt)
#pragma unroll
        for (int r = 0; r < 4; ++r) S[nt][r] = SAMPLE ? p.in[6][((size_t)(l * 16 + slot) * 8 + h) * 4096 + (16 * nt + fr) * 64 + 16 * w + 4 * fq + r] : 0.f;
    const float gb = exp2f(lg2gamma(h) * (float)BLK);
    const size_t tb0 = ((size_t)slot * 8 + h) * NCH;
    auto loadset = [&](int n, bf16x8 (&a)[KS], bf16x8 (&b)[4][KS]) {
        const size_t tb = (tb0 + n) * (size_t)(64 * BLK);
#pragma unroll
        for (int ks = 0; ks < KS; ++ks) { a[ks] = ld8(VTB + tb + (size_t)(16 * w + fr) * BLK + 8 * fq + 32 * ks);
#pragma unroll
            for (int nt = 0; nt < 4; ++nt) b[nt][ks] = ld8(KTB + tb + (size_t)(16 * nt + fr) * BLK + 8 * fq + 32 * ks); } };
    auto step = [&](int n, const bf16x8 (&a)[KS], const bf16x8 (&b)[4][KS]) {
        bf16_t* dst = SP + (tb0 + n) * 4096 + (size_t)(16 * w + 4 * fq) * 64 + fr;
#pragma unroll
        for (int nt = 0; nt < 4; ++nt) { f32x4 acc = {0.f, 0.f, 0.f, 0.f};
#pragma unroll
            for (int ks = 0; ks < KS; ++ks) acc = MFMA16(a[ks], b[nt][ks], acc);
#pragma unroll
            for (int r = 0; r < 4; ++r) dst[r * 64 + 16 * nt] = f2bf(S[nt][r]);
            S[nt] = S[nt] * gb + acc; } };
    bf16x8 a0[KS], b0[4][KS], a1[KS], b1[4][KS];
    loadset(0, a0, b0);
#pragma unroll 1
    for (int n = 0; n < NCH; n += 2) {
        if (n + 1 < NCH) loadset(n + 1, a1, b1);
        step(n, a0, b0);
        if (n + 1 < NCH) { if (n + 2 < NCH) loadset(n + 2, a0, b0); step(n + 1, a1, b1); }
    }
    float* o = retout + ((size_t)slot * 8 + h) * 4096 + 16 * w + 4 * fq;
#pragma unroll
    for (int nt = 0; nt < 4; ++nt)
#pragma unroll
        for (int r = 0; r < 4; ++r) o[(size_t)(16 * nt + fr) * 64 + r] = S[nt][r];
}

template <bool SAMPLE>
DI f32x4 lru_xrow4(const bf16_t* U, const float* sconv, size_t lrow, int t, int back, int ch) {
    const bool ok = (t - back >= 0);
    const f32x4 v = ld_bf4(U + (ok ? lrow - back : lrow) * 512 + ch);
    const float m = ok ? 1.f : 0.f;
    if (SAMPLE) { const f32x4 sv = *(const f32x4*)(sconv + (size_t)(ok ? 0 : 3 + t - back) * 512 + ch); return v * m + sv * (1.f - m); }
    return v * m;
}
typedef unsigned u32x4_t __attribute__((ext_vector_type(4)));
DI size_t lru_row(size_t lrow, int t, int back) { return (t - back >= 0) ? lrow - back : lrow; }
template <bool SAMPLE>
DI void lru_cvt8(u32x4_t w, const float* sconv, int t, int back, int ch, f32x4& lo, f32x4& hi) {
    const bool ok = (t - back >= 0); const float m = ok ? 1.f : 0.f;
    lo.x = __uint_as_float(w.x << 16); lo.y = __uint_as_float(w.x & 0xffff0000u); lo.z = __uint_as_float(w.y << 16); lo.w = __uint_as_float(w.y & 0xffff0000u);
    hi.x = __uint_as_float(w.z << 16); hi.y = __uint_as_float(w.z & 0xffff0000u); hi.z = __uint_as_float(w.w << 16); hi.w = __uint_as_float(w.w & 0xffff0000u);
    if (SAMPLE) { const float* sp = sconv + (size_t)(ok ? 0 : 3 + t - back) * 512 + ch; const f32x4 s0 = *(const f32x4*)sp, s1 = *(const f32x4*)(sp + 4);
        lo = lo * m + s0 * (1.f - m); hi = hi * m + s1 * (1.f - m); }
    else { lo = lo * m; hi = hi * m; }
}
template <bool SAMPLE>
DI f32x4 lru_cvt4(u32x2 w, const float* sconv, int t, int back, int ch) {
    const bool ok = (t - back >= 0); const float m = ok ? 1.f : 0.f;
    const f32x4 v = bf4_to_f(w);
    if (SAMPLE) { const f32x4 sv = *(const f32x4*)(sconv + (size_t)(ok ? 0 : 3 + t - back) * 512 + ch); return v * m + sv * (1.f - m); }
    return v * m;
}
template <int BLK, bool SAMPLE>
DI void lru_item(int item, const Params& p, int l, int lane, const LAS float* tbl, const bf16x8 (&wa)[4][2], const bf16x8 (&wx)[4][2]) {
    constexpr int T = SAMPLE ? 32 : 2048, NTG = T / 16;
    const int fr = lane & 15, fq = lane >> 4;
    const int c8 = item & 7, tg = (item >> 3) % NTG, slot = item / (8 * NTG);
    const bf16_t* U = (const bf16_t*)(p.ws + U_XR);
    const int t = 16 * tg + fr; const size_t lrow = (size_t)slot * T + t;
    const float* sconv = p.in[7] + (size_t)(l * 16 + slot) * 3 * 512;
    u32x4_t xbr[2][4]; u32x2 xcr[4][4];
#pragma unroll
    for (int ks = 0; ks < 2; ++ks)
#pragma unroll
        for (int j = 0; j < 4; ++j) xbr[ks][j] = *(const u32x4_t*)(U + lru_row(lrow, t, 3 - j) * 512 + c8 * 64 + 32 * ks + 8 * fq);
#pragma unroll
    for (int mt = 0; mt < 4; ++mt)
#pragma unroll
        for (int j = 0; j < 4; ++j) xcr[mt][j] = *(const u32x2*)(U + lru_row(lrow, t, 3 - j) * 512 + c8 * 64 + 16 * mt + 4 * fq);
    bf16x8 bx[2];
#pragma unroll
    for (int ks = 0; ks < 2; ++ks) {
        const int cl = 32 * ks + 8 * fq;
        f32x4 a0 = *(const LAS f32x4*)(tbl + 256 + cl), a1 = *(const LAS f32x4*)(tbl + 256 + cl + 4);
#pragma unroll
        for (int j = 0; j < 4; ++j) { f32x4 x0, x1; lru_cvt8<SAMPLE>(xbr[ks][j], sconv, t, 3 - j, c8 * 64 + cl, x0, x1);
            a0 += *(const LAS f32x4*)(tbl + j * 64 + cl) * x0; a1 += *(const LAS f32x4*)(tbl + j * 64 + cl + 4) * x1; }
        bx[ks] = pack8(a0, a1);
    }
    bf16_t* LH = (bf16_t*)(p.ws + W_LH); bf16_t* LPR = (bf16_t*)(p.ws + W_LPR); float* Pagg = (float*)(p.ws + W_PAGG); float* Hagg = (float*)(p.ws + W_HAGG);
#pragma unroll
    for (int mt = 0; mt < 4; ++mt) {
        f32x4 ga = {0.f, 0.f, 0.f, 0.f}, gx = {0.f, 0.f, 0.f, 0.f};
        ga = MFMA16(wa[mt][0], bx[0], ga); ga = MFMA16(wa[mt][1], bx[1], ga);
        gx = MFMA16(wx[mt][0], bx[0], gx); gx = MFMA16(wx[mt][1], bx[1], gx);
        const int cl = 16 * mt + 4 * fq; const int ch = c8 * 64 + cl;
        f32x4 xc = *(const LAS f32x4*)(tbl + 256 + cl);
#pragma unroll
        for (int j = 0; j < 4; ++j) xc += *(const LAS f32x4*)(tbl + j * 64 + cl) * lru_cvt4<SAMPLE>(xcr[mt][j], sconv, t, 3 - j, ch);
        const f32x4 ba = *(const LAS f32x4*)(tbl + 320 + cl), bg = *(const LAS f32x4*)(tbl + 384 + cl), c8sp = *(const LAS f32x4*)(tbl + 448 + cl);
        f32x4 av, bv;
#pragma unroll
        for (int r = 0; r < 4; ++r) {
            const float ra = sigm(ga[r] + ba[r]), ig = sigm(gx[r] + bg[r]);
            const float log_a = c8sp[r] * ra; av[r] = __expf(log_a);
            const float x2 = 2.0f * log_a;
            const float em = x2 > -0.3f ? x2 * (1.f + x2 * (0.5f + x2 * ((1.f / 6.f) + x2 * ((1.f / 24.f) + x2 * ((1.f / 120.f) + x2 * (1.f / 720.f)))))) : __expf(x2) - 1.f;
            bv[r] = __builtin_amdgcn_sqrtf(-em) * ig * xc[r];
        }
#pragma unroll
        for (int d = 1; d < 16; d <<= 1) {
#pragma unroll
            for (int r = 0; r < 4; ++r) { const float ap = shup16(av[r], lane, d), bp = shup16(bv[r], lane, d);
                if (fr >= d) { bv[r] = av[r] * bp + bv[r]; av[r] = av[r] * ap; } }
        }
        st_bf4(LPR + lrow * 512 + ch, av); st_bf4(LH + lrow * 512 + ch, bv);
        if (fr == 15) { *(f32x4*)(Pagg + ((size_t)slot * NTG + tg) * 512 + ch) = av; *(f32x4*)(Hagg + ((size_t)slot * NTG + tg) * 512 + ch) = bv; }
    }
}

template <int BLK, bool SAMPLE>
DI void ret_out_item(int item, const Params& p, int l, int lane) {
    constexpr int NQG = BLK / 16, NCH = SAMPLE ? 1 : 32, T = SAMPLE ? 32 : 2048;
    const int fr = lane & 15, fq = lane >> 4;
    const int w = item % NQG, h = (item / NQG) & 7, n = (item / (NQG * 8)) % NCH, slot = item / (NQG * 8 * NCH);
    const bf16_t* QB = (const bf16_t*)(p.ws + U_QB); const bf16_t* KB = (const bf16_t*)(p.ws + U_KB); const bf16_t* ZB = (const bf16_t*)(p.ws + U_ZB);
    const bf16_t* VTB = (const bf16_t*)(p.ws + W_VTB); const bf16_t* SP = (const bf16_t*)(p.ws + W_SP);
    bf16_t* Y = (bf16_t*)(p.ws + W_Y);
    const size_t r0 = (size_t)slot * T + n * BLK; const size_t qrow = r0 + 16 * w + fr;
    const float lg = lg2gamma(h);
    const size_t hm0 = (((size_t)slot * 8 + h) * T + n * BLK) * 64; const size_t qhm = hm0 + (size_t)(16 * w + fr) * 64;
    bf16x8 qf[2]; qf[0] = ld8(QB + qhm + 8 * fq); qf[1] = ld8(QB + qhm + 8 * fq + 32);
    f32x4 pin[NQG];
    const int iq = 16 * w + fr;
#pragma unroll
    for (int mt = 0; mt < NQG; ++mt) {
        { const int mtc = mt <= w ? mt : w; const bf16_t* kp = KB + hm0 + (size_t)(16 * mtc + fr) * 64 + 8 * fq;
            f32x4 z = {0.f, 0.f, 0.f, 0.f}; z = MFMA16(ld8(kp), qf[0], z); z = MFMA16(ld8(kp + 32), qf[1], z);
#pragma unroll
            for (int r = 0; r < 4; ++r) { const int dlt = iq - (16 * mt + 4 * fq + r); pin[mt][r] = dlt >= 0 ? z[r] * __builtin_amdgcn_exp2f(lg * (float)dlt) : 0.f; } }
    }
    const float xi = exp2f(lg * (float)(iq + 1));
    f32x4 y[4];
#pragma unroll
    for (int et = 0; et < 4; ++et) {
        f32x4 ay = {0.f, 0.f, 0.f, 0.f};
#pragma unroll
        for (int ks = 0; ks < NQG / 2; ++ks) { const bf16_t* vp = VTB + (((size_t)slot * 8 + h) * NCH + n) * (size_t)(64 * BLK) + (size_t)(16 * et + fr) * BLK + 32 * ks + 4 * fq;
            ay = MFMA16(ld4x2(vp, vp + 16), pack8(pin[2 * ks], pin[2 * ks + 1]), ay); }
        const bf16_t* sp = SP + ((size_t)(slot * 8 + h) * NCH + n) * 4096 + (16 * et + fr) * 64 + 8 * fq;
        f32x4 ax = {0.f, 0.f, 0.f, 0.f}; ax = MFMA16(ld8(sp), qf[0], ax); ax = MFMA16(ld8(sp + 32), qf[1], ax);
        y[et] = ay + ax * xi;
    }
    float sum = 0.f;
#pragma unroll
    for (int et = 0; et < 4; ++et) sum += y[et][0] + y[et][1] + y[et][2] + y[et][3];
    sum += shx(sum, lane, 16); sum += shx(sum, lane, 32);
    const float mu = sum * (1.0f / 64.0f);
    float vs = 0.f;
#pragma unroll
    for (int et = 0; et < 4; ++et)
#pragma unroll
        for (int r = 0; r < 4; ++r) { const float d = y[et][r] - mu; vs += d * d; }
    vs += shx(vs, lane, 16); vs += shx(vs, lane, 32);
    const float rs = rsqrtf(vs * (1.0f / 64.0f) + 1e-5f);
#pragma unroll
    for (int et = 0; et < 4; ++et) { const int col = h * 64 + 16 * et + 4 * fq;
        const f32x4 gn = *(const f32x4*)(p.in[11] + (size_t)l * 512 + col); const f32x4 z = ld_bf4(ZB + qhm + 16 * et + 4 * fq);
        f32x4 o; o.x = (y[et].x - mu) * rs * gn.x * z.x; o.y = (y[et].y - mu) * rs * gn.y * z.y; o.z = (y[et].z - mu) * rs * gn.z * z.z; o.w = (y[et].w - mu) * rs * gn.w * z.w;
        st_bf4(Y + qrow * 1536 + 512 + col, o); }
}

template <int BLK, bool SAMPLE>
DI void phase_mix1(const Params& p, int l, const Grp& g, LAS unsigned char* lds, int rep) {
    constexpr int NCH = SAMPLE ? 1 : 32, T = SAMPLE ? 32 : 2048;
    const int nslot = 16;
    const int nAB = nslot * NCH * 4, nR = nslot * NCH * 32, nL = nslot * (T / 16) * 8;
    const int tidl = tid_l(); const int wid = __builtin_amdgcn_readfirstlane(tidl >> 6), lane = tidl & 63;
    const int bid = bid_l();
    if (!SAMPLE && gridDim.x == 256) {
        const int x = bid & 7, j = bid >> 3;
        for (int k = 0; k < 8; ++k) { const int sidx = x + 8 * k; attn_block<BLK, SAMPLE>(((sidx >> 2) * NCH + ((j + 4 * k) & 31)) * 4 + (sidx & 3), p, l, tidl, lds); }
    } else
    for (int it = bid; it < nAB; it += gridDim.x) attn_block<BLK, SAMPLE>(it, p, l, tidl, lds);
    if (rep) return;
    const int gw = bid * 8 + wid, nw = gridDim.x * 8;
    constexpr int NCHAIN = 16 * 8 * 4;
    if (gw < NCHAIN) { ret_chain<BLK, SAMPLE>(gw, p, l, lane, p.out + (SAMPLE ? O_RS + (size_t)l * 16 * 8 * 4096 : O_RP + ((size_t)l * 32 + g.seq0) * 8 * 4096)); return; }
    LAS float* tbl = (LAS float*)(lds + AT_TAB + wid * 2048);
    bf16x8 wa[4][2], wx[4][2];
    { const int c8 = gw & 7, fr = lane & 15, fq = lane >> 4; const int ch = c8 * 64 + lane;
      const float* cw = p.in[12] + (size_t)l * 4 * 512;
      const float v0 = cw[ch], v1 = cw[512 + ch], v2 = cw[1024 + ch], v3 = cw[1536 + ch], v4 = p.in[13][(size_t)l * 512 + ch], v5 = p.in[15][(size_t)l * 512 + ch],
                  v6 = p.in[17][(size_t)l * 512 + ch], v7 = ((const float*)(p.ws + W_ROPE) + 131072)[(size_t)l * 512 + ch];
      tbl[lane] = v0; tbl[64 + lane] = v1; tbl[128 + lane] = v2; tbl[192 + lane] = v3; tbl[256 + lane] = v4; tbl[320 + lane] = v5; tbl[384 + lane] = v6; tbl[448 + lane] = v7;
      const bf16_t* WgT = (const bf16_t*)(p.ws + W_WG);
#pragma unroll
      for (int mt = 0; mt < 4; ++mt)
#pragma unroll
          for (int ks = 0; ks < 2; ++ks) { wa[mt][ks] = ld8(WgT + (size_t)((l * 2 + 0) * 8 + c8) * 4096 + (16 * mt + fr) * 64 + 8 * fq + 32 * ks);
              wx[mt][ks] = ld8(WgT + (size_t)((l * 2 + 1) * 8 + c8) * 4096 + (16 * mt + fr) * 64 + 8 * fq + 32 * ks); } }
#pragma unroll 1
    for (int it = gw - NCHAIN; it < nL; it += nw - NCHAIN) { LAS float* tb2 = tbl; asm volatile("" : "+v"(tb2));
        lru_item<BLK, SAMPLE>(it, p, l, lane, tb2, wa, wx); }
}
template <int BLK, bool SAMPLE>
DI void phase_scan(const Params& p, int l, const Grp& g) {
    constexpr int NCH = SAMPLE ? 1 : 32, T = SAMPLE ? 32 : 2048, NTG = T / 16;
    const int nslot = 16;
    const size_t gt = (size_t)bid_l() * 512 + tid_l(), gn = (size_t)gridDim.x * 512;
    float* Pagg = (float*)(p.ws + W_PAGG); float* Hagg = (float*)(p.ws + W_HAGG); float* Carry = (float*)(p.ws + W_CARRY);
    float* lruout = p.out + (SAMPLE ? O_LS + (size_t)l * 16 * 512 : O_LP + ((size_t)l * 32 + g.seq0) * 512);
    { const int tidl = tid_l(); const int wid = __builtin_amdgcn_readfirstlane(tidl >> 6), lane = tidl & 63;
      if (wid == 7) {
        constexpr int TB = NTG < 32 ? NTG : 32;
        for (int w = bid_l(); w < nslot * 8; w += gridDim.x) {
            const int slot = w >> 3, ch = (w & 7) * 64 + lane;
            float hh = SAMPLE ? p.in[8][(size_t)(l * 16 + slot) * 512 + ch] : 0.f;
            const size_t b = (size_t)slot * NTG * 512 + ch;
            for (int t0 = 0; t0 < NTG; t0 += TB) {
                float pa[TB], ha[TB];
#pragma unroll
                for (int i = 0; i < TB; ++i) { pa[i] = Pagg[b + (size_t)(t0 + i) * 512]; ha[i] = Hagg[b + (size_t)(t0 + i) * 512]; }
#pragma unroll
                for (int i = 0; i < TB; ++i) { Carry[b + (size_t)(t0 + i) * 512] = hh; hh = pa[i] * hh + ha[i]; }
            }
            lruout[(size_t)slot * 512 + ch] = hh;
        }
      } }
}
template <int BLK, bool SAMPLE>
DI void phase_mix2(const Params& p, int l, const Grp& g) {
    constexpr int NQG = BLK / 16, NCH = SAMPLE ? 1 : 32, T = SAMPLE ? 32 : 2048, NTG = T / 16;
    const int nslot = 16;
    const int nR = nslot * NCH * 8 * NQG;
    const int tidl = tid_l(); const int wid = __builtin_amdgcn_readfirstlane(tidl >> 6), lane = tidl & 63;
    const int gw = bid_l() * 8 + wid, nw = gridDim.x * 8;
    for (int it = gw; it < nR; it += nw) ret_out_item<BLK, SAMPLE>(it, p, l, lane);
    const bf16_t* ZC = (const bf16_t*)(p.ws + U_ZC); bf16_t* Y = (bf16_t*)(p.ws + W_Y);
    const bf16_t* LH = (const bf16_t*)(p.ws + W_LH); const bf16_t* LPR = (const bf16_t*)(p.ws + W_LPR); const float* Carry = (const float*)(p.ws + W_CARRY);
    const size_t gt = (size_t)bid_l() * 512 + tid_l(), gn = (size_t)gridDim.x * 512;
    for (size_t i = gt; i < (size_t)g.rows * 128; i += gn) { const size_t lrow = i >> 7; const int ch = (int)(i & 127) * 4;
        const int slot = (int)(lrow / T), t = (int)(lrow % T);
        const f32x4 c = *(const f32x4*)(Carry + ((size_t)slot * NTG + (t >> 4)) * 512 + ch);
        const f32x4 hv = ld_bf4(LPR + lrow * 512 + ch) * c + ld_bf4(LH + lrow * 512 + ch);
        st_bf4(Y + lrow * 1536 + 1024 + ch, hv * ld_bf4(ZC + lrow * 512 + ch)); }
}
DI void phase_ln(const Params& p, int l, const Grp& g) {
    const bf16_t* R2 = (const bf16_t*)(p.ws + W_RF); bf16_t* xb = (bf16_t*)(p.ws + W_XB);
    float* ydst = p.out + (g.sample ? O_YS : O_YP + g.grow0 * DM);
    const float* lg = p.in[21] + (size_t)l * DM; const float* lb = p.in[22] + (size_t)l * DM;
    const int tidl = tid_l(); const int wid = __builtin_amdgcn_readfirstlane(tidl >> 6), lane = tidl & 63;
    const int nwv = gridDim.x * 8;
    for (int row0 = bid_l() * 8 + wid; row0 < g.rows; row0 += 4 * nwv) {
        f32x4 v[4][4]; float s[4], q[4];
#pragma unroll
        for (int j = 0; j < 4; ++j) { const int row = row0 + j * nwv < g.rows ? row0 + j * nwv : row0; s[j] = 0.f;
#pragma unroll
            for (int i = 0; i < 4; ++i) { v[j][i] = ld_bf4(R2 + (size_t)row * DM + i * 256 + lane * 4); s[j] += v[j][i].x + v[j][i].y + v[j][i].z + v[j][i].w; } }
#pragma unroll
        for (int d = 1; d < 64; d <<= 1)
#pragma unroll
            for (int j = 0; j < 4; ++j) s[j] += shx(s[j], lane, d);
#pragma unroll
        for (int j = 0; j < 4; ++j) { const float mu = s[j] * (1.0f / 1024.0f); s[j] = mu; q[j] = 0.f;
#pragma unroll
            for (int i = 0; i < 4; ++i) { const f32x4 d = v[j][i] - mu; q[j] += d.x * d.x + d.y * d.y + d.z * d.z + d.w * d.w; } }
#pragma unroll
        for (int d = 1; d < 64; d <<= 1)
#pragma unroll
            for (int j = 0; j < 4; ++j) q[j] += shx(q[j], lane, d);
#pragma unroll
        for (int j = 0; j < 4; ++j) { const int row = row0 + j * nwv; if (row < g.rows) { const float rs = rsqrtf(q[j] * (1.0f / 1024.0f) + 1e-5f);
#pragma unroll
            for (int i = 0; i < 4; ++i) { const int col = i * 256 + lane * 4; const f32x4 o = (v[j][i] - s[j]) * rs * *(const f32x4*)(lg + col) + *(const f32x4*)(lb + col);
                if (l == 0) st_bf4(xb + (size_t)row * DM + col, o); else *(f32x4*)(ydst + (size_t)row * DM + col) = o; } } }
    }
}

#define XB_TMO      128
#define XB_XCNT(j)  (256  + 64 * (j))
#define XB_XSUB(j)  (1280 + 64 * (j))
#define XB_XGEN(j)  (2304 + 64 * (j))
#define XB_TOP      3328
#define XB_TOPGEN   3392
#define XCD_BAR_WORDS 3456
#define XB_SPIN_CAP (1u << 18)
DI unsigned xb_ld(unsigned* p)              { return __hip_atomic_load(p, __ATOMIC_RELAXED, __HIP_MEMORY_SCOPE_AGENT); }
DI unsigned xb_add(unsigned* p, unsigned v) { return __hip_atomic_fetch_add(p, v, __ATOMIC_RELAXED, __HIP_MEMORY_SCOPE_AGENT); }
DI unsigned xb_xcc_id() { return (unsigned)__builtin_amdgcn_s_getreg((3 << 11) | 20) & 0xFu; }
#define XB_SPIN(cond, bar) do { unsigned _sp = 0; while (cond) { __builtin_amdgcn_s_sleep(1); \
    if ((++_sp & 255u) == 0u) { if (xb_ld(&(bar)[XB_TMO])) break; if (_sp > XB_SPIN_CAP) { atomicAdd(&(bar)[XB_TMO], 1u); break; } } } } while (0)
struct XcdBarrier { unsigned* bar; unsigned x; volatile LAS unsigned* st; };
DI XcdBarrier xcd_barrier_post(unsigned* bar, volatile LAS unsigned* st) {
    XcdBarrier b; b.bar = bar; b.x = xb_xcc_id(); b.st = st;
    if (threadIdx.x == 0) (void)xb_add(&bar[XB_XCNT(b.x)], 1u);
    return b;
}
DI void xcd_barrier_complete(unsigned* bar, unsigned x, unsigned& nloc, unsigned& nx) {
    const unsigned G = gridDim.x * gridDim.y * gridDim.z;
    unsigned sum, cnt, mine, sp = 0u;
    for (;;) {
        sum = 0u; cnt = 0u; mine = 0u;
#pragma unroll
        for (unsigned j = 0; j < 16; ++j) { const unsigned c = xb_ld(&bar[XB_XCNT(j)]); sum += c; cnt += (c > 0u) ? 1u : 0u; mine = (j == x) ? c : mine; }
        if (sum == G) break;
        __builtin_amdgcn_s_sleep(1);
        if ((++sp & 255u) == 0u) { if (xb_ld(&bar[XB_TMO])) break; if (sp > XB_SPIN_CAP) { atomicAdd(&bar[XB_TMO], 1u); break; } }
    }
    nloc = mine > 0u ? mine : 1u; nx = cnt > 0u ? cnt : 1u;
}
DI void xcd_barrier(const XcdBarrier& b) {
    asm volatile("s_waitcnt vmcnt(0)" ::: "memory");
    __syncthreads();
    if (threadIdx.x == 0) {
        unsigned* bar = b.bar;
        __builtin_amdgcn_s_waitcnt(0);
        unsigned nloc = b.st[0], nx = b.st[1];
        if (nloc == 0u) { xcd_barrier_complete(bar, b.x, nloc, nx); b.st[0] = nloc; b.st[1] = nx; }
        const unsigned old = xb_add(&bar[XB_XSUB(b.x)], 1u);
        const unsigned gen = old / nloc;
        if (old + 1u == (gen + 1u) * nloc) {
            __builtin_amdgcn_fence(__ATOMIC_RELEASE, "agent");
            asm volatile("s_waitcnt vmcnt(0)" ::: "memory");
            const unsigned og = xb_add(&bar[XB_TOP], 1u);
            const unsigned tg = og / nx;
            if (og + 1u == (tg + 1u) * nx) xb_add(&bar[XB_TOPGEN], 1u);
            else XB_SPIN(xb_ld(&bar[XB_TOPGEN]) == tg, bar);
            __builtin_amdgcn_fence(__ATOMIC_ACQUIRE, "agent");
            xb_add(&bar[XB_XGEN(b.x)], 1u);
            asm volatile("s_waitcnt vmcnt(0)" ::: "memory");
        } else {
            XB_SPIN(xb_ld(&bar[XB_XGEN(b.x)]) == gen, bar);
            __builtin_amdgcn_fence(__ATOMIC_ACQUIRE, "agent");
            asm volatile("s_waitcnt vmcnt(0)" ::: "memory");
        }
    }
    __syncthreads();
}
#ifndef PHMASK
#define PHMASK 511
#endif
#ifndef DUPMASK
#define DUPMASK 0
#endif
__global__ void __launch_bounds__(512, 2) fwd_megakernel(Params p0) {
    extern __shared__ __attribute__((aligned(16))) unsigned char smem[];
    cg::grid_group grid = cg::this_grid();
    LAS unsigned char* lds = (LAS unsigned char*)smem;
    volatile LAS unsigned* xst = (volatile LAS unsigned*)(lds + pg8::STAGE_BYTES);
    if (threadIdx.x == 0) { xst[0] = 0u; xst[1] = 0u; xst[2] = 0u; xst[3] = 0u; }
    __syncthreads();
    const XcdBarrier xbar = xcd_barrier_post((unsigned*)(p0.ws + W_BAR), xst);
    const int ph_lo = p0.ph_lo, ph_hi = p0.ph_hi;
    for (int ph = ph_lo; ph < ph_hi; ++ph) {
        typedef const Params __attribute__((address_space(4))) CParams;
        CParams* pp = (CParams*)__builtin_amdgcn_kernarg_segment_ptr();
        asm volatile("" : "+s"(pp));
#if defined(__HIP_DEVICE_COMPILE__)
        const Params p = *pp;
#else
        const Params p = p0;
#endif
        if (ph == 0) { if (PHMASK & 256) phase_prep(p, (float*)smem); }
        else for (int rep = 0; rep < (((DUPMASK >> ((ph - 1) & 7)) & 1) ? 2 : 1); ++rep) {
            if (rep) xcd_barrier(xbar);
            const int q = ph - 1, k = q & 7, l = (q >> 3) & 1, gi = q >> 4;
            const Grp g = mkgrp(gi);
            pg8::StaticOrder S;
            if (k == 0 && (PHMASK & 1)) {
                EpiIn E; E.ws = p.ws;
                E.SK = (bf16_t*)(p.ws + W_SK) + (size_t)l * 16 * 576 * 512; E.SVT = (bf16_t*)(p.ws + W_SVT) + (size_t)l * 16 * 512 * 576;
                E.outK = p.out + (g.sample ? O_KS + (size_t)l * 16 * 32 * 512 : O_KP + (size_t)l * 32 * 512 * 512);
                E.outV = p.out + (g.sample ? O_VS + (size_t)l * 16 * 32 * 512 : O_VP + (size_t)l * 32 * 512 * 512);
                E.outConv = p.out + (g.sample ? O_CS + (size_t)l * 16 * 3 * 512 : O_CP + (size_t)l * 32 * 3 * 512);
                E.rope = (const float*)(p.ws + W_ROPE); E.sample = g.sample; E.seq0 = g.seq0; E.T = g.T; E.blk = g.sample ? 32 : 64; E.nch = g.sample ? 1 : 32;
                pg8::Gemm gm{(const bf16_t*)(p.ws + W_XB), (const bf16_t*)(p.ws + W_WIN) + (size_t)l * NIN * DM, g.rows, NIN, DM};
                S.init(gm.M, gm.N, gridDim.x, bid_l()); pg8::gemm_phase(lds, gm, S, E);
            } else if (k == 1 && (PHMASK & 2)) { if (g.sample) phase_mix1<32, true>(p, l, g, lds, 0); else phase_mix1<64, false>(p, l, g, lds, 0);
            } else if (k == 2 && (PHMASK & 4)) { if (g.sample) phase_scan<32, true>(p, l, g); else phase_scan<64, false>(p, l, g);
            } else if (k == 3 && (PHMASK & 8)) { if (g.sample) phase_mix2<32, true>(p, l, g); else phase_mix2<64, false>(p, l, g);
            } else if (k == 4 && (PHMASK & 16)) {
                EpiMerge E; E.U = (const bf16_t*)(p.ws + U_GS); E.Mb = (bf16_t*)(p.ws + W_MB);
                pg8::Gemm gm{(const bf16_t*)(p.ws + W_Y), (const bf16_t*)(p.ws + W_WBR) + (size_t)l * DM * 1536, g.rows, DM, 1536};
                S.init(gm.M, gm.N, gridDim.x, bid_l()); pg8::gemm_phase(lds, gm, S, E);
            } else if (k == 5 && (PHMASK & 32)) {
                EpiOut E; E.xb = (const bf16_t*)(p.ws + W_XB); E.Rb = (bf16_t*)(p.ws + W_RB);
                pg8::Gemm gm{(const bf16_t*)(p.ws + W_MB), (const bf16_t*)(p.ws + W_WOUT) + (size_t)l * DM * DM, g.rows, DM, DM};
                S.init(gm.M, gm.N, gridDim.x, bid_l()); pg8::gemm_phase(lds, gm, S, E);
                EpiPE E2; E2.PE = (bf16_t*)(p.ws + W_PE);
                pg8::Gemm g2{(const bf16_t*)(p.ws + W_PB) + (size_t)l * RG * 256, (const bf16_t*)(p.ws + W_WPE) + (size_t)l * DM * 256, g.rows, DM, 256};
                S.init(g2.M, g2.N, gridDim.x, bid_l()); pg8::gemm_phase(lds, g2, S, E2);
            } else if (k == 6 && (PHMASK & 64)) {
                EpiGate E; E.PE = (const bf16_t*)(p.ws + W_PE); E.Rb = (const bf16_t*)(p.ws + W_RB); E.R2 = (bf16_t*)(p.ws + W_RF);
                pg8::Gemm gm{(const bf16_t*)(p.ws + W_RB), (const bf16_t*)(p.ws + W_WPG) + (size_t)l * DM * DM, g.rows, DM, DM};
                S.init(gm.M, gm.N, gridDim.x, bid_l()); pg8::gemm_phase(lds, gm, S, E);
            } else if (PHMASK & 128) {
                phase_ln(p, l, g);
                if (l == 1 && gi + 1 < NGROUP) group_convert(p, gi + 1);
            }
        }
        if (ph + 1 < ph_hi) { if (ph_lo < 0) grid.sync();
            xcd_barrier(xbar); }
    }
}

extern "C" void kernel_launch(void* const* d_in, const int* in_sizes, int n_in, void* d_out, int out_size, void* d_ws, size_t ws_size, hipStream_t stream) {
    static int grid_blocks = 0;
    constexpr size_t kDynLds = pg8::STAGE_BYTES + 16;
    if (!grid_blocks) {
        if (n_in != 25 || ws_size < W_END) { fprintf(stderr, "kernel_launch: unexpected n_in %d or ws_size %zu (< %zu)\n", n_in, ws_size, (size_t)W_END); grid_blocks = -1; return; }
        int dev = 0, cus = 0, per_cu = 0;
        (void)hipGetDevice(&dev);
        (void)hipDeviceGetAttribute(&cus, hipDeviceAttributeMultiprocessorCount, dev);
        (void)hipFuncSetAttribute((const void*)fwd_megakernel, hipFuncAttributeMaxDynamicSharedMemorySize, (int)kDynLds);
        (void)hipOccupancyMaxActiveBlocksPerMultiprocessor(&per_cu, (const void*)fwd_megakernel, 512, kDynLds);
        if (per_cu < 1) per_cu = 1;
        grid_blocks = cus * per_cu;
        if (grid_blocks > 256) grid_blocks = 256;
    }
    if (grid_blocks < 0) return;
    Params p{};
    for (int i = 0; i < 25; ++i) p.in[i] = (const float*)d_in[i];
    p.out = (float*)d_out; p.ws = (unsigned char*)d_ws; p.ph_lo = 0; p.ph_hi = 1 + NGROUP * 16;
    (void)hipMemsetAsync((unsigned char*)d_ws + W_BAR, 0, XCD_BAR_WORDS * 4, stream);
    void* args[] = {&p};
    hipError_t e = hipLaunchCooperativeKernel((const void*)fwd_megakernel, dim3(grid_blocks), dim3(512), args, kDynLds, stream);
    if (e != hipSuccess) fprintf(stderr, "cooperative launch failed: %s (grid %d)\n", hipGetErrorString(e), grid_blocks);
}
```

```cpp
#include <hip/hip_runtime.h>
#include <hip/hip_cooperative_groups.h>
#include <cstdio>
namespace cg = cooperative_groups;

#define DI __device__ __forceinline__
#define LAS __attribute__((address_space(3)))
typedef unsigned short bf16_t;
typedef short bf16x8 __attribute__((ext_vector_type(8)));
typedef short s16x4 __attribute__((ext_vector_type(4)));
typedef float f32x4 __attribute__((ext_vector_type(4)));
typedef unsigned u32x2 __attribute__((ext_vector_type(2)));

constexpr int DM = 1024, NIN = 8192, PROWS = 65536, SROWS = 512, NGROUP = 3, RG = 32768, NSLOT_P = 16;
constexpr float ALPHA_C = 1.4142135623730951f;
constexpr float NEGINF = -1e30f;
constexpr size_t O_YP = 0, O_YS = 67108864, O_KP = 67633152, O_VP = 84410368, O_KS = 101187584, O_VS = 101711872,
                 O_RP = 102236160, O_RS = 104333312, O_CP = 105381888, O_CS = 105480192, O_LP = 105529344, O_LS = 105562112;
constexpr size_t MiB = 1048576;
constexpr size_t W_WIN = 0;
constexpr size_t W_WBR = W_WIN + 32 * MiB;
constexpr size_t W_WOUT = W_WBR + 6 * MiB;
constexpr size_t W_WPG = W_WOUT + 4 * MiB;
constexpr size_t W_WPE = W_WPG + 4 * MiB;
constexpr size_t W_WG = W_WPE + 1 * MiB;
constexpr size_t W_ROPE = W_WG + 1 * MiB;
constexpr size_t W_SK = W_ROPE + 1 * MiB;
constexpr size_t W_SVT = W_SK + 19 * MiB;
constexpr size_t W_XB = W_SVT + 19 * MiB;
constexpr size_t W_PB = W_XB + 64 * MiB;
constexpr size_t W_U = W_PB + 32 * MiB;
constexpr size_t U_QA = W_U, U_KA = W_U + 32 * MiB, U_ZA = W_U + 64 * MiB, U_QB = W_U + 96 * MiB, U_KB = W_U + 128 * MiB, U_ZB = W_U + 160 * MiB,
                 U_XR = W_U + 192 * MiB, U_ZC = W_U + 224 * MiB, U_GS = W_U + 256 * MiB;
constexpr size_t W_VTA = W_U + 448 * MiB;
constexpr size_t W_KTB = W_VTA + 32 * MiB;
constexpr size_t W_VTB = W_KTB + 32 * MiB;
constexpr size_t W_KV = W_VTB + 32 * MiB;
constexpr size_t W_SP = W_KV + 64 * MiB;
constexpr size_t W_LH = W_SP + 32 * MiB;
constexpr size_t W_LPR = W_LH + 32 * MiB;
constexpr size_t W_PAGG = W_LPR + 32 * MiB;
constexpr size_t W_HAGG = W_PAGG + 4 * MiB;
constexpr size_t W_CARRY = W_HAGG + 4 * MiB;
constexpr size_t W_Y = W_CARRY + 4 * MiB;
constexpr size_t W_BAR = W_Y + 96 * MiB;
constexpr size_t W_END = W_BAR + 1 * MiB;
constexpr size_t W_MB = U_QA;
constexpr size_t W_RB = U_ZA;
constexpr size_t W_RF = U_KB;
constexpr size_t W_PE = U_XR;
static_assert(W_END <= 1024 * MiB, "workspace layout exceeds 1 GiB");

struct Params {
    const float* in[25];
    float* out;
    unsigned char* ws;
    int ph_lo, ph_hi;
};

typedef __bf16 bf16x2_t __attribute__((ext_vector_type(2)));
typedef float f32x2_t __attribute__((ext_vector_type(2)));
DI unsigned pk2(float lo, float hi) { f32x2_t f = {lo, hi}; bf16x2_t b = __builtin_convertvector(f, bf16x2_t); return __builtin_bit_cast(unsigned, b); }
DI bf16_t f2bf(float f) { return (bf16_t)(pk2(f, 0.f) & 0xffffu); }
DI float bf2f(unsigned short x) { return __uint_as_float(((unsigned)x) << 16); }
DI void st_bf4(bf16_t* p, f32x4 v) { u32x2 w; w.x = pk2(v.x, v.y); w.y = pk2(v.z, v.w); *(u32x2*)p = w; }
DI f32x4 ld_bf4(const bf16_t* p) { u32x2 w = *(const u32x2*)p; f32x4 v; v.x = __uint_as_float(w.x << 16); v.y = __uint_as_float(w.x & 0xffff0000u);
    v.z = __uint_as_float(w.y << 16); v.w = __uint_as_float(w.y & 0xffff0000u); return v; }
DI f32x4 bf4_to_f(u32x2 w) { f32x4 v; v.x = __uint_as_float(w.x << 16); v.y = __uint_as_float(w.x & 0xffff0000u); v.z = __uint_as_float(w.y << 16); v.w = __uint_as_float(w.y & 0xffff0000u); return v; }
DI bf16x8 ld8(const bf16_t* p) { return *(const bf16x8*)p; }
DI bf16x8 ld4x2(const bf16_t* p0, const bf16_t* p1) { s16x4 a = *(const s16x4*)p0, b = *(const s16x4*)p1; return __builtin_shufflevector(a, b, 0, 1, 2, 3, 4, 5, 6, 7); }
DI bf16x8 pack8(f32x4 a, f32x4 b) { typedef unsigned u32x4 __attribute__((ext_vector_type(4))); u32x4 w; w.x = pk2(a.x, a.y); w.y = pk2(a.z, a.w); w.z = pk2(b.x, b.y); w.w = pk2(b.z, b.w); return __builtin_bit_cast(bf16x8, w); }
DI float sigm(float x) { return __builtin_amdgcn_rcpf(1.0f + __expf(-x)); }
DI float sigm_d(float x) { return 1.0f / (1.0f + __expf(-x)); }
DI float lg2gamma(int h) { float x = __uint_as_float((unsigned)(127 - 5 - h) << 23); return -(x + x * x * 0.5f + x * x * x * (1.f / 3.f) + x * x * x * x * 0.25f + x * x * x * x * x * 0.2f) * 1.4426950408889634f; }
DI int tid_l() { int t = threadIdx.x; asm volatile("" : "+v"(t)); return t; }
DI int bid_l() { int b = blockIdx.x; asm volatile("" : "+s"(b)); return b; }
DI float shx(float v, int lane, int m) { return __int_as_float(__builtin_amdgcn_ds_bpermute((lane ^ m) << 2, __float_as_int(v))); }
DI float shup16(float v, int lane, int d) { return __int_as_float(__builtin_amdgcn_ds_bpermute((((lane & 15) >= d) ? lane - d : lane) << 2, __float_as_int(v))); }
#define MFMA16(a, b, c) __builtin_amdgcn_mfma_f32_16x16x32_bf16((a), (b), (c), 0, 0, 0)

namespace pg8 {
constexpr int BM = 256, BK = 64, HALF = 128, HTB = HALF * BK * 2, STAGE_BYTES = 8 * HTB, NXCD = 8, WGM = 8;
DI int lds_byte(int r, int c) { const int st = (r >> 4) * 2 + (c >> 5), rr = r & 15, cc = c & 31, ob = rr * 64 + cc * 2; return st * 1024 + (ob ^ (((ob >> 9) & 1) << 5)); }
DI void stage_rc(int b, int& R, int& C) { const int st = b / 1024, sb = b % 1024, swz = sb ^ (((sb >> 9) & 1) << 5); R = (st >> 1) * 16 + swz / 64; C = (st & 1) * 32 + (swz % 64) / 2; }
struct Unit { int pm, pn; };
struct Gemm { const bf16_t* A; const bf16_t* Bt; int M, N, K; };
struct StaticOrder {
    int nM, nN, nwg, G, c;
    DI void init(int M, int N, int G_, int c_) { nM = M / BM; nN = N / BM; nwg = nM * nN; G = G_; c = c_; }
    DI bool next(int i, Unit& u) const {
        const long L = (long)i * G + c; if (L >= nwg) return false;
        int wgid = (int)L; { const int q = nwg / NXCD, r = nwg % NXCD, xcd = wgid % NXCD, off = wgid / NXCD; wgid = (xcd < r ? xcd * (q + 1) : r * (q + 1) + (xcd - r) * q) + off; }
        const int nig = WGM * nN, gid = wgid / nig, fm = gid * WGM, gsz = (nM - fm) < WGM ? (nM - fm) : WGM;
        u.pm = fm + ((wgid % nig) % gsz); u.pn = (wgid % nig) / gsz; return true;
    }
};
template <class Epi>
DI void gemm_phase(LAS unsigned char* lds, const Gemm g, const StaticOrder& S, const Epi& E) {
    const int tid = tid_l(), wid = __builtin_amdgcn_readfirstlane(tid >> 6), lane = tid & 63, wr = wid >> 2, wc = wid & 3, fr = lane & 15, fq = lane >> 4;
    const int K = g.K, nt = K / BK;
    unsigned voffA[2];
#pragma unroll
    for (int i = 0; i < 2; ++i) { int R, C; stage_rc(tid * 16 + i * 8192, R, C); voffA[i] = (unsigned)(R * K + C) * 2u; }
    const size_t kstep = (size_t)(BK * 2);
    const size_t hstep = (size_t)HALF * K * 2;
    const size_t tstep = 2 * hstep;
    const unsigned ldsw = (unsigned)wid * 1024u;
    const int aoff = lds_byte(wr * 64 + fr, fq * 8), boff = lds_byte(wc * 32 + fr, fq * 8);
#define PG8_SA(b, h) (((b) * 2 + (h)) * HTB)
#define PG8_SB(b, h) ((4 + (b) * 2 + (h)) * HTB)
#define PG8_STAGE(bufoff, gbase) do { _Pragma("unroll") for (int _i = 0; _i < 2; ++_i) \
        __builtin_amdgcn_global_load_lds((const unsigned*)((const char*)(gbase) + voffA[_i]), (LAS unsigned*)(lds + (bufoff) + ldsw + _i * 8192), 16, 0, 0); } while (0)
#define PG8_LDA(dst, b, h) do { _Pragma("unroll") for (int m = 0; m < 4; ++m) _Pragma("unroll") for (int k = 0; k < 2; ++k) dst[m][k] = *(const LAS bf16x8*)(lds + PG8_SA(b, h) + aoff + m * 2048 + k * 1024); } while (0)
#define PG8_LDB(dst, b, h) do { _Pragma("unroll") for (int n = 0; n < 2; ++n) _Pragma("unroll") for (int k = 0; k < 2; ++k) dst[n][k] = *(const LAS bf16x8*)(lds + PG8_SB(b, h) + boff + n * 2048 + k * 1024); } while (0)
#define PG8_MMA(ai, bj, At, Bt) do { __builtin_amdgcn_s_setprio(1); _Pragma("unroll") for (int m = 0; m < 4; ++m) _Pragma("unroll") for (int n = 0; n < 2; ++n) _Pragma("unroll") for (int k = 0; k < 2; ++k) \
        acc[ai][bj][m][n] = __builtin_amdgcn_mfma_f32_16x16x32_bf16(Bt[n][k], At[m][k], acc[ai][bj][m][n], 0, 0, 0); __builtin_amdgcn_s_setprio(0); } while (0)
#define PG8_WAIT_V(n) asm volatile("s_waitcnt vmcnt(" #n ")" ::: "memory")
#define PG8_WAIT_L(n) asm volatile("s_waitcnt lgkmcnt(" #n ")" ::: "memory")
#define PG8_BAR __builtin_amdgcn_s_barrier()
#define PG8_SCHED __builtin_amdgcn_sched_barrier(0)
    Unit cur, nxt; int ui = 0;
    if (!S.next(0, cur)) return;
    f32x4 acc[2][2][4][2];
#pragma unroll
    for (int a = 0; a < 2; ++a)
#pragma unroll
        for (int b = 0; b < 2; ++b)
#pragma unroll
            for (int m = 0; m < 4; ++m)
#pragma unroll
                for (int n = 0; n < 2; ++n) acc[a][b][m][n] = (f32x4){0.f, 0.f, 0.f, 0.f};
    bf16x8 At[4][2], B0[2][2], B1[2][2];
    const char* cA = (const char*)g.A + (size_t)cur.pm * tstep; const char* cB = (const char*)g.Bt + (size_t)cur.pn * tstep;
    PG8_STAGE(PG8_SB(0, 0), cB); PG8_STAGE(PG8_SA(0, 0), cA); PG8_STAGE(PG8_SB(0, 1), cB + hstep); PG8_STAGE(PG8_SA(0, 1), cA + hstep);
    if (wr == 1) PG8_BAR;
    PG8_WAIT_V(4); PG8_BAR;
    PG8_STAGE(PG8_SB(1, 0), cB + kstep); PG8_STAGE(PG8_SA(1, 0), cA + kstep); PG8_STAGE(PG8_SB(1, 1), cB + hstep + kstep);
    PG8_WAIT_V(6); PG8_BAR;
    for (;;) {
        const bool has_next = S.next(ui + 1, nxt);
        const char* nA = has_next ? (const char*)g.A + (size_t)nxt.pm * tstep : cA; const char* nB = has_next ? (const char*)g.Bt + (size_t)nxt.pn * tstep : cB;
        for (int t = 0; t < nt; t += 2) {
            const bool last = (t == nt - 2);
            const char* a1 = cA + (size_t)(t + 1) * kstep;
            const char* a2 = last ? nA : cA + (size_t)(t + 2) * kstep; const char* b2 = last ? nB : cB + (size_t)(t + 2) * kstep;
            const char* a3 = a2 + kstep; const char* b3 = b2 + kstep;
            if constexpr (Epi::HAS_MID) { if (t == 8 || t == 16) { E.mid(acc, cur, t, wr, wc, fr, fq); PG8_SCHED; } }
            PG8_LDB(B0, 0, 0); PG8_SCHED; PG8_LDA(At, 0, 0); PG8_STAGE(PG8_SA(1, 1), a1 + hstep);
            PG8_WAIT_L(8); PG8_BAR; PG8_WAIT_L(0); PG8_MMA(0, 0, At, B0); PG8_BAR; PG8_SCHED;
            PG8_LDB(B1, 0, 1); PG8_STAGE(PG8_SB(0, 0), b2);
            PG8_BAR; PG8_WAIT_L(0); PG8_MMA(0, 1, At, B1); PG8_BAR;
            PG8_LDA(At, 0, 1); PG8_STAGE(PG8_SA(0, 0), a2);
            PG8_BAR; PG8_WAIT_L(0); PG8_MMA(1, 0, At, B0); PG8_BAR; PG8_SCHED;
            PG8_STAGE(PG8_SB(0, 1), b2 + hstep);
            PG8_WAIT_V(6); PG8_BAR; PG8_MMA(1, 1, At, B1); PG8_BAR;
            PG8_LDB(B0, 1, 0); PG8_SCHED; PG8_LDA(At, 1, 0); PG8_STAGE(PG8_SA(0, 1), a2 + hstep);
            PG8_WAIT_L(8); PG8_BAR; PG8_WAIT_L(0); PG8_MMA(0, 0, At, B0); PG8_BAR; PG8_SCHED;
            PG8_LDB(B1, 1, 1); PG8_STAGE(PG8_SB(1, 0), b3);
            PG8_BAR; PG8_WAIT_L(0); PG8_MMA(0, 1, At, B1); PG8_BAR;
            PG8_LDA(At, 1, 1); PG8_STAGE(PG8_SA(1, 0), a3);
            PG8_BAR; PG8_WAIT_L(0); PG8_MMA(1, 0, At, B0); PG8_BAR; PG8_SCHED;
            PG8_STAGE(PG8_SB(1, 1), b3 + hstep);
            PG8_WAIT_V(6); PG8_BAR; PG8_MMA(1, 1, At, B1); PG8_BAR;
        }
        E(acc, cur, wr, wc, fr, fq);
        if (!has_next) break;
#pragma unroll
        for (int a = 0; a < 2; ++a)
#pragma unroll
            for (int b = 0; b < 2; ++b)
#pragma unroll
                for (int m = 0; m < 4; ++m)
#pragma unroll
                    for (int n = 0; n < 2; ++n) acc[a][b][m][n] = (f32x4){0.f, 0.f, 0.f, 0.f};
        cur = nxt; cA = nA; cB = nB; ++ui;
    }
    PG8_WAIT_V(0);
    if (wr == 0) PG8_BAR;
    PG8_BAR;
#undef PG8_SA
#undef PG8_SB
#undef PG8_STAGE
#undef PG8_LDA
#undef PG8_LDB
#undef PG8_MMA
#undef PG8_WAIT_V
#undef PG8_WAIT_L
#undef PG8_BAR
#undef PG8_SCHED
}
}
using pg8::Unit;

template <int MB, class LF, class BF>
DI void epi_ai_loop2(const Unit& u, int wr, int wc, int fr, int fq, LF&& loads, BF&& body) {
#pragma unroll
    for (int ai = 0; ai < 2; ++ai)
#pragma unroll
      for (int m0 = 0; m0 < 4; m0 += MB) {
#pragma unroll
        for (int m = m0; m < m0 + MB; ++m)
#pragma unroll
            for (int bj = 0; bj < 2; ++bj)
#pragma unroll
                for (int n = 0; n < 2; ++n) loads(ai, m, bj, n, u.pm * 256 + ai * 128 + wr * 64 + m * 16 + fr, u.pn * 256 + bj * 128 + wc * 32 + n * 16 + 4 * fq);
        __builtin_amdgcn_sched_barrier(0);
#pragma unroll
        for (int m = m0; m < m0 + MB; ++m)
#pragma unroll
            for (int bj = 0; bj < 2; ++bj)
#pragma unroll
                for (int n = 0; n < 2; ++n) body(ai, m, bj, n, u.pm * 256 + ai * 128 + wr * 64 + m * 16 + fr, u.pn * 256 + bj * 128 + wc * 32 + n * 16 + 4 * fq);
        __builtin_amdgcn_sched_barrier(0);
      }
}
struct EpiIn {
    static constexpr bool HAS_MID = false;
    unsigned char* ws; bf16_t *SK, *SVT; float *outK, *outV, *outConv; const float* rope; int sample, seq0, T, blk, nch;
    template <int R> DI void body(const f32x4 (&acc)[2][2][4][2], const Unit& u, int wr, int wc, int fr, int fq) const {
        const int colt = u.pn * 256;
        bf16_t* const QA = (bf16_t*)(ws + U_QA); bf16_t* const KA = (bf16_t*)(ws + U_KA); bf16_t* const ZA = (bf16_t*)(ws + U_ZA);
        bf16_t* const QB = (bf16_t*)(ws + U_QB); bf16_t* const KB = (bf16_t*)(ws + U_KB); bf16_t* const ZB = (bf16_t*)(ws + U_ZB);
        bf16_t* const XR = (bf16_t*)(ws + U_XR); bf16_t* const ZC = (bf16_t*)(ws + U_ZC); bf16_t* const GS = (bf16_t*)(ws + U_GS);
        bf16_t* const TVA = (bf16_t*)(ws + W_VTA); bf16_t* const TKB = (bf16_t*)(ws + W_KTB); bf16_t* const TVB = (bf16_t*)(ws + W_VTB);
#pragma unroll
        for (int ai = 0; ai < 2; ++ai)
#pragma unroll
            for (int m = 0; m < 4; ++m) {
                int frx = fr; asm volatile("" : "+v"(frx));
                const int lrow = u.pm * 256 + ai * 128 + wr * 64 + m * 16 + frx;
                int slot, t, pos;
                if (sample) { slot = lrow >> 5; t = lrow & 31; pos = 1024 + t; } else { slot = lrow >> 11; t = lrow & 2047; pos = t; }
#pragma unroll
                for (int bj = 0; bj < 2; ++bj)
#pragma unroll
                    for (int n = 0; n < 2; ++n) {
                        const int col = colt + bj * 128 + wc * 32 + n * 16 + 4 * fq;
                        const int c = col & 511, h = c >> 6, d = c & 63;
                        const size_t hm = (((size_t)slot * 8 + h) * T + t) * 64 + d;
                        const size_t tm = (((size_t)slot * 8 + h) * nch + (sample ? 0 : (t >> 6))) * (size_t)(64 * blk) + (size_t)d * blk + (t & (blk - 1));
                        f32x4 v = acc[ai][bj][m][n];
                        if constexpr (R == 0) { st_bf4(QA + hm, v * (0.125f * 1.4426950408889634f)); }
                        else if constexpr (R == 1) {
                            if (sample) { st_bf4(SK + ((size_t)(slot * 576 + 512 + t)) * 512 + c, v); *(f32x4*)(outK + (size_t)(slot * 32 + t) * 512 + c) = v; }
                            else { st_bf4(KA + hm, v); if (t >= 1536) *(f32x4*)(outK + ((size_t)(seq0 + slot) * 512 + (t - 1536)) * 512 + c) = v; }
                        } else if constexpr (R == 2) {
                            if (sample) { bf16_t* dd = SVT + ((size_t)(slot * 512 + c)) * 576 + 512 + t; dd[0] = f2bf(v.x); dd[576] = f2bf(v.y); dd[2 * 576] = f2bf(v.z); dd[3 * 576] = f2bf(v.w);
                                *(f32x4*)(outV + (size_t)(slot * 32 + t) * 512 + c) = v; }
                            else { bf16_t* dd = TVA + tm; dd[0] = f2bf(v.x); dd[64] = f2bf(v.y); dd[128] = f2bf(v.z); dd[192] = f2bf(v.w);
                                if (t >= 1536) *(f32x4*)(outV + ((size_t)(seq0 + slot) * 512 + (t - 1536)) * 512 + c) = v; }
                        } else if constexpr (R == 3 || R == 7 || R == 9) {
                            f32x4 o; o.x = v.x * sigm(v.x); o.y = v.y * sigm(v.y); o.z = v.z * sigm(v.z); o.w = v.w * sigm(v.w);
                            if constexpr (R == 3) st_bf4(ZA + hm, o); else if constexpr (R == 7) st_bf4(ZB + hm, o); else st_bf4(ZC + (size_t)lrow * 512 + c, o);
                        } else if constexpr (R == 4 || R == 5) {
                            const int i0 = d >> 1;
                            const float c0 = rope[pos * 32 + i0], c1 = rope[pos * 32 + i0 + 1], s0 = rope[65536 + pos * 32 + i0], s1 = rope[65536 + pos * 32 + i0 + 1];
                            float o1a = v.x * c0 - v.y * s0, o2a = v.x * s0 + v.y * c0, o1b = v.z * c1 - v.w * s1, o2b = v.z * s1 + v.w * c1;
                            if constexpr (R == 5) { o1a *= 0.125f; o2a *= 0.125f; o1b *= 0.125f; o2b *= 0.125f; }
                            bf16_t* dst = (R == 4 ? QB : KB) + (hm - d);
                            *(unsigned*)(dst + i0) = pk2(o1a, o1b); *(unsigned*)(dst + 32 + i0) = pk2(o2a, o2b);
                            if constexpr (R == 5) {
                                const float zeta = exp2f(lg2gamma(h) * (float)(blk - 1 - (t & (blk - 1))));
                                bf16_t* dd = TKB + (tm - (size_t)d * blk) + (size_t)i0 * blk;
                                dd[0] = f2bf(o1a * zeta); dd[blk] = f2bf(o1b * zeta); dd[(size_t)32 * blk] = f2bf(o2a * zeta); dd[(size_t)33 * blk] = f2bf(o2b * zeta);
                            }
                        } else if constexpr (R == 6) {
                            bf16_t* dd = TVB + tm; dd[0] = f2bf(v.x); dd[blk] = f2bf(v.y); dd[2 * blk] = f2bf(v.z); dd[3 * blk] = f2bf(v.w);
                        } else if constexpr (R == 8) {
                            st_bf4(XR + (size_t)lrow * 512 + c, v);
                            if (sample) { if (t >= 29) *(f32x4*)(outConv + (size_t)(slot * 3 + t - 29) * 512 + c) = v; }
                            else { if (t >= 2045) *(f32x4*)(outConv + (size_t)((seq0 + slot) * 3 + t - 2045) * 512 + c) = v; }
                        } else {
                            f32x4 o; o.x = sigm(v.x); o.y = sigm(v.y); o.z = sigm(v.z); o.w = sigm(v.w);
                            const int cg = col - 5120, b = cg >> 10, pn4 = (cg >> 8) & 3;
                            st_bf4(GS + ((((size_t)b * (RG / 256) + u.pm) * 4 + pn4) << 16) + (size_t)(lrow & 255) * 256 + (cg & 255), o);
                        }
                    }
                __builtin_amdgcn_sched_barrier(0);
            }
    }
    template <int R> DI void body_rope(const f32x4 (&acc)[2][2][4][2], const Unit& u, int wr, int wc, int fr, int fq) const {
        bf16_t* const QB = (bf16_t*)(ws + U_QB); bf16_t* const KB = (bf16_t*)(ws + U_KB); bf16_t* const TKB = (bf16_t*)(ws + W_KTB);
        f32x2_t cv[4][2][2], sv[4][2][2];
        epi_ai_loop2<4>(u, wr, wc, fr, fq,
            [&](int ai, int m, int bj, int n, int lrow, int col) { const int t = sample ? (lrow & 31) : (lrow & 2047), pos = sample ? 1024 + t : t, i0 = (col & 63) >> 1;
                cv[m][bj][n] = *(const f32x2_t*)(rope + pos * 32 + i0); sv[m][bj][n] = *(const f32x2_t*)(rope + 65536 + pos * 32 + i0); },
            [&](int ai, int m, int bj, int n, int lrow, int col) {
                int slot, t; if (sample) { slot = lrow >> 5; t = lrow & 31; } else { slot = lrow >> 11; t = lrow & 2047; }
                const int c = col & 511, h = c >> 6, d = c & 63, i0 = d >> 1;
                const size_t hm = (((size_t)slot * 8 + h) * T + t) * 64;
                const f32x4 v = acc[ai][bj][m][n]; const float c0 = cv[m][bj][n].x, c1 = cv[m][bj][n].y, s0 = sv[m][bj][n].x, s1 = sv[m][bj][n].y;
                float o1a = v.x * c0 - v.y * s0, o2a = v.x * s0 + v.y * c0, o1b = v.z * c1 - v.w * s1, o2b = v.z * s1 + v.w * c1;
                if constexpr (R == 5) { o1a *= 0.125f; o2a *= 0.125f; o1b *= 0.125f; o2b *= 0.125f; }
                bf16_t* dst = (R == 4 ? QB : KB) + hm;
                *(unsigned*)(dst + i0) = pk2(o1a, o1b); *(unsigned*)(dst + 32 + i0) = pk2(o2a, o2b);
                if constexpr (R == 5) {
                    const float zeta = exp2f(lg2gamma(h) * (float)(blk - 1 - (t & (blk - 1))));
                    bf16_t* dd = TKB + (((size_t)slot * 8 + h) * nch + (sample ? 0 : (t >> 6))) * (size_t)(64 * blk) + (size_t)i0 * blk + (t & (blk - 1));
                    dd[0] = f2bf(o1a * zeta); dd[blk] = f2bf(o1b * zeta); dd[(size_t)32 * blk] = f2bf(o2a * zeta); dd[(size_t)33 * blk] = f2bf(o2b * zeta);
                } });
    }
    DI void operator()(const f32x4 (&acc)[2][2][4][2], const Unit& u, int wr, int wc, int fr, int fq) const {
        const int region = (u.pn * 256) >> 9;
        switch (region) {
            case 0: body<0>(acc, u, wr, wc, fr, fq); break;
            case 1: body<1>(acc, u, wr, wc, fr, fq); break;
            case 2: body<2>(acc, u, wr, wc, fr, fq); break;
            case 3: body<3>(acc, u, wr, wc, fr, fq); break;
            case 7: body<7>(acc, u, wr, wc, fr, fq); break;
            case 9: body<9>(acc, u, wr, wc, fr, fq); break;
            case 4: body_rope<4>(acc, u, wr, wc, fr, fq); break;
            case 5: body_rope<5>(acc, u, wr, wc, fr, fq); break;
            case 6: body<6>(acc, u, wr, wc, fr, fq); break;
            case 8: body<8>(acc, u, wr, wc, fr, fq); break;
            default: body<10>(acc, u, wr, wc, fr, fq); break;
        }
    }
};
#define EPI_LOOP(...) \
    _Pragma("unroll") for (int ai = 0; ai < 2; ++ai) _Pragma("unroll") for (int m = 0; m < 4; ++m) { \
        const int lrow = u.pm * 256 + ai * 128 + wr * 64 + m * 16 + fr; \
        _Pragma("unroll") for (int bj = 0; bj < 2; ++bj) _Pragma("unroll") for (int n = 0; n < 2; ++n) { \
            const int col = u.pn * 256 + bj * 128 + wc * 32 + n * 16 + 4 * fq; __VA_ARGS__ } __builtin_amdgcn_sched_barrier(0); }
struct EpiPE { static constexpr bool HAS_MID = false; bf16_t* PE;
    DI void operator()(const f32x4 (&acc)[2][2][4][2], const Unit& u, int wr, int wc, int fr, int fq) const {
        EPI_LOOP({ st_bf4(PE + (size_t)lrow * DM + col, acc[ai][bj][m][n]); }) } };
struct EpiMerge { static constexpr bool HAS_MID = true; const bf16_t* U; bf16_t* Mb;
    DI size_t goff(int lrow, int col, int b) const { return ((((size_t)b * (RG / 256) + (lrow >> 8)) * 4 + (col >> 8)) << 16) + (size_t)(lrow & 255) * 256 + (col & 255); }
    DI void mid(f32x4 (&acc)[2][2][4][2], const Unit& u, int t, int wr, int wc, int fr, int fq) const {
        const int b = (t >> 3) - 1;
        u32x2 g0[4][2][2], g1[4][2][2];
        epi_ai_loop2<4>(u, wr, wc, fr, fq, [&](int ai, int m, int bj, int n, int lrow, int col) { const size_t o = goff(lrow, col, b); g0[m][bj][n] = *(const u32x2*)(U + o); g1[m][bj][n] = *(const u32x2*)(U + o + (size_t)(RG / 256) * 4 * 65536); }, [&](int ai, int m, int bj, int n, int lrow, int col) { const f32x4 a0 = bf4_to_f(g0[m][bj][n]), a1 = bf4_to_f(g1[m][bj][n]); f32x4 a = acc[ai][bj][m][n];
                       a.x *= fmaxf(a0.x, 1e-20f) * __builtin_amdgcn_rcpf(fmaxf(a1.x, 1e-20f)); a.y *= fmaxf(a0.y, 1e-20f) * __builtin_amdgcn_rcpf(fmaxf(a1.y, 1e-20f));
                       a.z *= fmaxf(a0.z, 1e-20f) * __builtin_amdgcn_rcpf(fmaxf(a1.z, 1e-20f)); a.w *= fmaxf(a0.w, 1e-20f) * __builtin_amdgcn_rcpf(fmaxf(a1.w, 1e-20f));
                       acc[ai][bj][m][n] = a; });
    }
    DI void operator()(const f32x4 (&acc)[2][2][4][2], const Unit& u, int wr, int wc, int fr, int fq) const {
        u32x2 g2[4][2][2];
        epi_ai_loop2<4>(u, wr, wc, fr, fq, [&](int ai, int m, int bj, int n, int lrow, int col) { g2[m][bj][n] = *(const u32x2*)(U + goff(lrow, col, 2)); }, [&](int ai, int m, int bj, int n, int lrow, int col) { f32x4 g = bf4_to_f(g2[m][bj][n]); g.x = fmaxf(g.x, 1e-20f); g.y = fmaxf(g.y, 1e-20f); g.z = fmaxf(g.z, 1e-20f); g.w = fmaxf(g.w, 1e-20f);
                       st_bf4(Mb + (size_t)lrow * DM + col, acc[ai][bj][m][n] * g); });
    } };
struct EpiOut { static constexpr bool HAS_MID = false; const bf16_t* xb; bf16_t* Rb;
    DI void operator()(const f32x4 (&acc)[2][2][4][2], const Unit& u, int wr, int wc, int fr, int fq) const {
        u32x2 xv[4][2][2];
        epi_ai_loop2<4>(u, wr, wc, fr, fq, [&](int ai, int m, int bj, int n, int lrow, int col) { xv[m][bj][n] = *(const u32x2*)(xb + (size_t)lrow * DM + col); },
            [&](int ai, int m, int bj, int n, int lrow, int col) { const f32x4 r = bf4_to_f(xv[m][bj][n]) * ALPHA_C + acc[ai][bj][m][n]; st_bf4(Rb + (size_t)lrow * DM + col, r); });
    } };
struct EpiGate { static constexpr bool HAS_MID = false; const bf16_t* PE; const bf16_t* Rb; bf16_t* R2;
    DI void operator()(const f32x4 (&acc)[2][2][4][2], const Unit& u, int wr, int wc, int fr, int fq) const {
        u32x2 rv[4][2][2], pv[4][2][2];
        epi_ai_loop2<4>(u, wr, wc, fr, fq, [&](int ai, int m, int bj, int n, int lrow, int col) { rv[m][bj][n] = *(const u32x2*)(Rb + (size_t)lrow * DM + col); pv[m][bj][n] = *(const u32x2*)(PE + (size_t)lrow * DM + col); },
            [&](int ai, int m, int bj, int n, int lrow, int col) { const f32x4 pe = bf4_to_f(pv[m][bj][n]); f32x4 r = bf4_to_f(rv[m][bj][n]); const f32x4 a = acc[ai][bj][m][n];
                       r.x += sigm(a.x) * pe.x; r.y += sigm(a.y) * pe.y; r.z += sigm(a.z) * pe.z; r.w += sigm(a.w) * pe.w; st_bf4(R2 + (size_t)lrow * DM + col, r); });
    } };

struct Grp { int gi, sample, rows, nslot, T, seq0; size_t grow0; };
DI Grp mkgrp(int gi) { Grp g; g.gi = gi; g.sample = (gi == NGROUP - 1); g.rows = g.sample ? SROWS : RG; g.nslot = 16; g.T = g.sample ? 32 : 2048; g.seq0 = gi * NSLOT_P; g.grow0 = (size_t)gi * RG; return g; }

DI void transpose_tile(const float* src, int srcN, bf16_t* dst, int dstStride, int k0, int n0, bool perm, float* tile) {
    const int tid = tid_l();
#pragma unroll
    for (int i = 0; i < 8; ++i) { const int kk = (tid >> 6) + 8 * i, nn = tid & 63; int nc = n0 + nn;
        if (perm) { const int hp = nc & 63; nc = (nc & ~63) + (hp >> 1) + 32 * (hp & 1); }
        tile[kk * 65 + nn] = src[(size_t)(k0 + kk) * srcN + nc]; }
    __syncthreads();
#pragma unroll
    for (int i = 0; i < 8; ++i) { const int nn = (tid >> 6) + 8 * i, kk = tid & 63; dst[(size_t)(n0 + nn) * dstStride + k0 + kk] = f2bf(tile[kk * 65 + nn]); }
}
DI void group_convert(const Params& p, int gi) {
    const Grp g = mkgrp(gi);
    bf16_t* xb = (bf16_t*)(p.ws + W_XB); bf16_t* pb = (bf16_t*)(p.ws + W_PB);
    const float* xs = g.sample ? p.in[1] : p.in[0] + g.grow0 * DM;
    const size_t gt = (size_t)bid_l() * 512 + tid_l(), gn = (size_t)gridDim.x * 512;
    const size_t nx = (size_t)g.rows * DM / 4;
    for (size_t i = gt; i < nx; i += gn) st_bf4(xb + i * 4, *(const f32x4*)(xs + i * 4));
    const size_t np = (size_t)g.rows * 256 / 4;
    for (int l = 0; l < 2; ++l) {
        const float* ps = g.sample ? p.in[3] + (size_t)l * SROWS * 256 : p.in[2] + ((size_t)l * PROWS + g.grow0) * 256;
        bf16_t* pd = pb + (size_t)l * RG * 256;
        for (size_t i = gt; i < np; i += gn) st_bf4(pd + i * 4, *(const f32x4*)(ps + i * 4));
    }
}
DI void phase_prep(const Params& p, float* tile) {
    bf16_t* WinT = (bf16_t*)(p.ws + W_WIN); bf16_t* WbrT = (bf16_t*)(p.ws + W_WBR); bf16_t* WoutT = (bf16_t*)(p.ws + W_WOUT);
    bf16_t* WpgT = (bf16_t*)(p.ws + W_WPG); bf16_t* WpeT = (bf16_t*)(p.ws + W_WPE); bf16_t* WgT = (bf16_t*)(p.ws + W_WG);
    bf16_t* SK = (bf16_t*)(p.ws + W_SK); bf16_t* SVT = (bf16_t*)(p.ws + W_SVT); float* rope = (float*)(p.ws + W_ROPE);
    constexpr int N0 = 4096, N1 = N0 + 768, N2 = N1 + 512, N3 = N2 + 512, N4 = N3 + 128, N5 = N4 + 32, N6 = N5 + 2048;
    float* const tile0 = tile; int par = 0;
    for (int it = bid_l(); it < N6; it += gridDim.x) {
        tile = tile0 + par * (64 * 65 + 15); par ^= 1;
        if (it < N0) { const int l = it >> 11, r = it & 2047, kt = r >> 7, ntl = r & 127; const int n0 = ntl * 64;
            transpose_tile(p.in[9] + (size_t)l * DM * NIN, NIN, WinT + (size_t)l * NIN * DM, DM, kt * 64, n0, n0 >= 2048 && n0 < 3072, tile);
        } else if (it < N1) { const int j = it - N0, lb = j >> 7, r = j & 127, kt = r >> 4, ntl = r & 15; const int l = lb / 3, b = lb % 3;
            transpose_tile(p.in[19] + (size_t)lb * 512 * DM, DM, WbrT + (size_t)l * DM * 1536 + b * 512, 1536, kt * 64, ntl * 64, false, tile);
        } else if (it < N2) { const int j = it - N1, l = j >> 8, r = j & 255;
            transpose_tile(p.in[20] + (size_t)l * DM * DM, DM, WoutT + (size_t)l * DM * DM, DM, (r >> 4) * 64, (r & 15) * 64, false, tile);
        } else if (it < N3) { const int j = it - N2, l = j >> 8, r = j & 255;
            transpose_tile(p.in[24] + (size_t)l * DM * DM, DM, WpgT + (size_t)l * DM * DM, DM, (r >> 4) * 64, (r & 15) * 64, false, tile);
        } else if (it < N4) { const int j = it - N3, l = j >> 6, r = j & 63;
            transpose_tile(p.in[23] + (size_t)l * 256 * DM, DM, WpeT + (size_t)l * DM * 256, 256, (r >> 4) * 64, (r & 15) * 64, false, tile);
        } else if (it < N5) { const int j = it - N4, l = j >> 4, which = (j >> 3) & 1, nb = j & 7;
            transpose_tile(p.in[which ? 16 : 14] + (size_t)(l * 8 + nb) * 4096, 64, WgT + (size_t)((l * 2 + which) * 8 + nb) * 4096, 64, 0, 0, false, tile);
        } else { const int j = it - N5, lb = j >> 6, r = j & 63;
            transpose_tile(p.in[5] + (size_t)lb * 512 * 512, 512, SVT + (size_t)lb * 512 * 576, 576, (r >> 3) * 64, (r & 7) * 64, false, tile);
        }
    }
    const size_t gt = (size_t)bid_l() * 512 + tid_l(), gn = (size_t)gridDim.x * 512;
    for (size_t i = gt; i < (size_t)32 * 576 * 128; i += gn) { const size_t lb = i / (576 * 128); const int rem = (int)(i % (576 * 128)), r = rem >> 7, c4 = (rem & 127) * 4;
        f32x4 v = {0.f, 0.f, 0.f, 0.f}; if (r < 512) v = *(const f32x4*)(p.in[4] + (lb * 512 + r) * 512 + c4);
        st_bf4(SK + (lb * 576 + r) * 512 + c4, v); }
    for (size_t i = gt; i < (size_t)32 * 512 * 16; i += gn) { const size_t row = i >> 4; const int c4 = (int)(i & 15) * 4; st_bf4(SVT + row * 576 + 512 + c4, (f32x4){0.f, 0.f, 0.f, 0.f}); }
    for (size_t i = gt; i < 65536; i += gn) { const int pos = (int)(i >> 5), k = (int)(i & 31);
        const float inv = exp2f(-(float)k * (13.287712379549449f / 32.0f)); const float ang = (float)pos * inv;
        const double rev = (double)ang * 0.15915494309189535; const float fr = (float)(rev - rint(rev));
        rope[i] = __builtin_amdgcn_cosf(fr); rope[65536 + i] = __builtin_amdgcn_sinf(fr); }
    { float* spl = rope + 131072;
      for (size_t i = gt; i < 1024; i += gn) { const float nl = -p.in[18][i]; spl[i] = -8.0f * (fmaxf(nl, 0.f) + log1pf(expf(-fabsf(nl)))); } }
    group_convert(p, 0);
}

constexpr int AT_ROWB = 144, AT_HEADB = 64 * AT_ROWB, AT_BUFB = 4 * AT_HEADB, AT_TAB = 2 * AT_BUFB;
template <int BLK, bool SAMPLE>
DI void attn_block(int item, const Params& p, int l, int tid, LAS unsigned char* lds) {
    constexpr int NCH = SAMPLE ? 1 : 32, T = SAMPLE ? 32 : 2048;
    const int wid = __builtin_amdgcn_readfirstlane(tid >> 6), lane = tid & 63, fr = lane & 15, fq = lane >> 4;
    const int hh = wid >> 2, w = wid & 3;
    const int hp = item & 3, c = (item >> 2) % NCH, slot = item / (4 * NCH);
    const int h = 2 * hp + hh;
    bf16_t* Y = (bf16_t*)(p.ws + W_Y);
    const size_t qrow = (size_t)slot * T + c * 64 + 16 * w + fr;
    const size_t qhm = (((size_t)slot * 8 + h) * T + c * 64 + 16 * w + fr) * 64;
    const bf16_t* QA = (const bf16_t*)(p.ws + U_QA); const bf16_t* ZA = (const bf16_t*)(p.ws + U_ZA);
    const int sh = tid >> 8, srow = (tid & 255) >> 2, scol = tid & 3;
    const bf16_t* Kg; const bf16_t* Vg; size_t ktile, vtile; int kr_base, o_start;
    if (SAMPLE) { Kg = (const bf16_t*)(p.ws + W_SK) + ((size_t)(l * 16 + slot) * 576 + srow) * 512 + (2 * hp + sh) * 64 + scol * 8; ktile = (size_t)64 * 512;
        Vg = (const bf16_t*)(p.ws + W_SVT) + ((size_t)(l * 16 + slot) * 512 + (2 * hp + sh) * 64 + srow) * 576 + scol * 8; vtile = 64; kr_base = 0; o_start = 0; }
    else { Kg = (const bf16_t*)(p.ws + U_KA) + (((size_t)slot * 8 + 2 * hp + sh) * 2048 + srow) * 64 + scol * 8; ktile = 4096;
        Vg = (const bf16_t*)(p.ws + W_VTA) + (((size_t)slot * 8 + 2 * hp + sh) * 32) * 4096 + srow * 64 + scol * 8; vtile = 4096; kr_base = c - 8; o_start = c < 8 ? 8 - c : 0; }
    const unsigned sdst = (unsigned)(sh * AT_HEADB + srow * AT_ROWB + scol * 16);
    LAS float* tl = (LAS float*)(lds + AT_TAB + wid * 2048);
    { const float* tab = p.in[10] + (size_t)(l * 8 + h) * 257;
      const float t0 = tab[lane], t1 = tab[lane + 64], t2 = tab[lane + 128], t3 = tab[lane + 192], t4 = tab[256];
      const float L2E = 1.4426950408889634f; tl[lane] = t0 * L2E; tl[lane + 64] = t1 * L2E; tl[lane + 128] = t2 * L2E; tl[lane + 192] = t3 * L2E; if (lane == 0) tl[256] = t4 * L2E; }
    bf16x8 qf[2];
    qf[0] = ld8(QA + qhm + 8 * fq); qf[1] = ld8(QA + qhm + 8 * fq + 32);
    u32x2 zg[4];
#pragma unroll
    for (int dt = 0; dt < 4; ++dt) zg[dt] = *(const u32x2*)(ZA + qhm + 16 * dt + 4 * fq);
    f32x4 oacc[4];
#pragma unroll
    for (int i = 0; i < 4; ++i) oacc[i] = (f32x4){0.f, 0.f, 0.f, 0.f};
    float mrun = NEGINF, lrun = 0.f;
    const int iq = 16 * w + fr;
    bf16x8 g0, g1, g2, g3;
    { const size_t tk = (size_t)(kr_base + o_start) * ktile, tv = (size_t)(kr_base + o_start) * vtile;
      g0 = ld8(Kg + tk); g1 = ld8(Kg + tk + 32); g2 = ld8(Vg + tv); g3 = ld8(Vg + tv + 32); }
    __syncthreads();
    *(LAS bf16x8*)(lds + sdst) = g0; *(LAS bf16x8*)(lds + sdst + 64) = g1; *(LAS bf16x8*)(lds + sdst + 2 * AT_HEADB) = g2; *(LAS bf16x8*)(lds + sdst + 2 * AT_HEADB + 64) = g3;
    __syncthreads();
    const float tab256 = tl[256];
    const unsigned kfo = (unsigned)(hh * AT_HEADB + fr * AT_ROWB + fq * 16), vfo = (unsigned)(2 * AT_HEADB + hh * AT_HEADB + fr * AT_ROWB + fq * 8);
    int buf = 0;
    for (int o = o_start; o < 9; ++o) {
        if (o < 8) { const size_t tk = (size_t)(kr_base + o + 1) * ktile, tv = (size_t)(kr_base + o + 1) * vtile;
            g0 = ld8(Kg + tk); g1 = ld8(Kg + tk + 32); g2 = ld8(Vg + tv); g3 = ld8(Vg + tv + 32); }
        LAS unsigned char* bb = lds + buf * AT_BUFB;
        f32x4 s[4];
#pragma unroll
        for (int mt = 0; mt < 4; ++mt) { const bf16x8 k0 = *(const LAS bf16x8*)(bb + kfo + mt * 16 * AT_ROWB), k1 = *(const LAS bf16x8*)(bb + kfo + mt * 16 * AT_ROWB + 64);
            f32x4 z = {0.f, 0.f, 0.f, 0.f}; z = MFMA16(k0, qf[0], z); s[mt] = MFMA16(k1, qf[1], z); }
        float tmax = NEGINF;
#pragma unroll
        for (int mt = 0; mt < 4; ++mt)
#pragma unroll
            for (int r = 0; r < 4; ++r) { const int jj = 16 * mt + 4 * fq + r; float b = tab256;
                if (o > 5) { int diff = 512 + iq - 64 * o - jj; diff = diff > 128 ? 128 : diff; b = tl[diff + 128]; }
                float v = s[mt][r] + b; if (SAMPLE && o == 8 && jj >= 32) v = NEGINF; s[mt][r] = v; tmax = fmaxf(tmax, v); }
        tmax = fmaxf(tmax, shx(tmax, lane, 16)); tmax = fmaxf(tmax, shx(tmax, lane, 32));
        const float mnew = fmaxf(mrun, tmax), alpha = __builtin_amdgcn_exp2f(mrun - mnew); mrun = mnew;
        float psum = 0.f;
#pragma unroll
        for (int mt = 0; mt < 4; ++mt)
#pragma unroll
            for (int r = 0; r < 4; ++r) { const float e = __builtin_amdgcn_exp2f(s[mt][r] - mnew); s[mt][r] = e; psum += e; }
        lrun = lrun * alpha + psum;
        const bf16x8 pb0 = pack8(s[0], s[1]), pb1 = pack8(s[2], s[3]);
#pragma unroll
        for (int dt = 0; dt < 4; ++dt) {
            const LAS unsigned char* vp = bb + vfo + dt * 16 * AT_ROWB;
            const s16x4 a0 = *(const LAS s16x4*)(vp), a1 = *(const LAS s16x4*)(vp + 32), a2 = *(const LAS s16x4*)(vp + 64), a3 = *(const LAS s16x4*)(vp + 96);
            f32x4 a = oacc[dt] * alpha; a = MFMA16(__builtin_shufflevector(a0, a1, 0, 1, 2, 3, 4, 5, 6, 7), pb0, a);
            oacc[dt] = MFMA16(__builtin_shufflevector(a2, a3, 0, 1, 2, 3, 4, 5, 6, 7), pb1, a); }
        if (o < 8) { LAS unsigned char* nb = lds + (buf ^ 1) * AT_BUFB;
            *(LAS bf16x8*)(nb + sdst) = g0; *(LAS bf16x8*)(nb + sdst + 64) = g1; *(LAS bf16x8*)(nb + sdst + 2 * AT_HEADB) = g2; *(LAS bf16x8*)(nb + sdst + 2 * AT_HEADB + 64) = g3; }
        __syncthreads();
        buf ^= 1;
    }
    lrun += shx(lrun, lane, 16); lrun += shx(lrun, lane, 32);
    const float inv = __builtin_amdgcn_rcpf(lrun);
    if (!SAMPLE || w < 2) {
#pragma unroll
        for (int dt = 0; dt < 4; ++dt) { const int col = h * 64 + 16 * dt + 4 * fq; const f32x4 g = bf4_to_f(zg[dt]); st_bf4(Y + qrow * 1536 + col, oacc[dt] * inv * g); }
    }
}

template <int BLK, bool SAMPLE>
DI void ret_chain(int chain, const Params& p, int l, int lane, float* retout) {
    constexpr int NCH = SAMPLE ? 1 : 32, KS = BLK / 32;
    const int fr = lane & 15, fq = lane >> 4;
    const int w = chain & 3, h = (chain >> 2) & 7, slot = chain >> 5;
    const bf16_t* KTB = (const bf16_t*)(p.ws + W_KTB); const bf16_t* VTB = (const bf16_t*)(p.ws + W_VTB); bf16_t* SP = (bf16_t*)(p.ws + W_SP);
    f32x4 S[4];
#pragma unroll
    for (int nt = 0; nt < 4; ++nt)
#pragma unroll
        for (int r = 0; r < 4; ++r) S[nt][r] = SAMPLE ? p.in[6][((size_t)(l * 16 + slot) * 8 + h) * 4096 + (16 * nt + fr) * 64 + 16 * w + 4 * fq + r] : 0.f;
    const float gb = exp2f(lg2gamma(h) * (float)BLK);
    const size_t tb0 = ((size_t)slot * 8 + h) * NCH;
    auto loadset = [&](int n, bf16x8 (&a)[KS], bf16x8 (&b)[4][KS]) {
        const size_t tb = (tb0 + n) * (size_t)(64 * BLK);
#pragma unroll
        for (int ks = 0; ks < KS; ++ks) { a[ks] = ld8(VTB + tb + (size_t)(16 * w + fr) * BLK + 8 * fq + 32 * ks);
#pragma unroll
            for (int nt = 0; nt < 4; ++nt) b[nt][ks] = ld8(KTB + tb + (size_t)(16 * nt + fr) * BLK + 8 * fq + 32 * ks); } };
    auto step = [&](int n, const bf16x8 (&a)[KS], const bf16x8 (&b)[4][KS]) {
        bf16_t* dst = SP + (tb0 + n) * 4096 + (size_t)(16 * w + 4 * fq) * 64 + fr;
#pragma unroll
        for (int nt = 0; nt < 4; ++nt) { f32x4 acc = {0.f, 0.f, 0.f, 0.f};
#pragma unroll
            for (int ks = 0; ks < KS; ++ks) acc = MFMA16(a[ks], b[nt][ks], acc);
#pragma unroll
            for (int r = 0; r < 4; ++r) dst[r * 64 + 16 * nt] = f2bf(S[nt][r]);
            S[nt] = S[nt] * gb + acc; } };
    bf16x8 a0[KS], b0[4][KS], a1[KS], b1[4][KS];
    loadset(0, a0, b0);
#pragma unroll 1
    for (int n = 0; n < NCH; n += 2) {
        if (n + 1 < NCH) loadset(n + 1, a1, b1);
        step(n, a0, b0);
        if (n + 1 < NCH) { if (n + 2 < NCH) loadset(n + 2, a0, b0); step(n + 1, a1, b1); }
    }
    float* o = retout + ((size_t)slot * 8 + h) * 4096 + 16 * w + 4 * fq;
#pragma unroll
    for (int nt = 0; nt < 4; ++nt)
#pragma unroll
        for (int r = 0; r < 4; ++r) o[(size_t)(16 * nt + fr) * 64 + r] = S[nt][r];
}

template <bool SAMPLE>
DI f32x4 lru_xrow4(const bf16_t* U, const float* sconv, size_t lrow, int t, int back, int ch) {
    const bool ok = (t - back >= 0);
    const f32x4 v = ld_bf4(U + (ok ? lrow - back : lrow) * 512 + ch);
    const float m = ok ? 1.f : 0.f;
    if (SAMPLE) { const f32x4 sv = *(const f32x4*)(sconv + (size_t)(ok ? 0 : 3 + t - back) * 512 + ch); return v * m + sv * (1.f - m); }
    return v * m;
}
typedef unsigned u32x4_t __attribute__((ext_vector_type(4)));
DI size_t lru_row(size_t lrow, int t, int back) { return (t - back >= 0) ? lrow - back : lrow; }
template <bool SAMPLE>
DI void lru_cvt8(u32x4_t w, const float* sconv, int t, int back, int ch, f32x4& lo, f32x4& hi) {
    const bool ok = (t - back >= 0); const float m = ok ? 1.f : 0.f;
    lo.x = __uint_as_float(w.x << 16); lo.y = __uint_as_float(w.x & 0xffff0000u); lo.z = __uint_as_float(w.y << 16); lo.w = __uint_as_float(w.y & 0xffff0000u);
    hi.x = __uint_as_float(w.z << 16); hi.y = __uint_as_float(w.z & 0xffff0000u); hi.z = __uint_as_float(w.w << 16); hi.w = __uint_as_float(w.w & 0xffff0000u);
    if (SAMPLE) { const float* sp = sconv + (size_t)(ok ? 0 : 3 + t - back) * 512 + ch; const f32x4 s0 = *(const f32x4*)sp, s1 = *(const f32x4*)(sp + 4);
        lo = lo * m + s0 * (1.f - m); hi = hi * m + s1 * (1.f - m); }
    else { lo = lo * m; hi = hi * m; }
}
template <bool SAMPLE>
DI f32x4 lru_cvt4(u32x2 w, const float* sconv, int t, int back, int ch) {
    const bool ok = (t - back >= 0); const float m = ok ? 1.f : 0.f;
    const f32x4 v = bf4_to_f(w);
    if (SAMPLE) { const f32x4 sv = *(const f32x4*)(sconv + (size_t)(ok ? 0 : 3 + t - back) * 512 + ch); return v * m + sv * (1.f - m); }
    return v * m;
}
template <int BLK, bool SAMPLE>
DI void lru_item(int item, const Params& p, int l, int lane, const LAS float* tbl, const bf16x8 (&wa)[4][2], const bf16x8 (&wx)[4][2]) {
    constexpr int T = SAMPLE ? 32 : 2048, NTG = T / 16;
    const int fr = lane & 15, fq = lane >> 4;
    const int c8 = item & 7, tg = (item >> 3) % NTG, slot = item / (8 * NTG);
    const bf16_t* U = (const bf16_t*)(p.ws + U_XR);
    const int t = 16 * tg + fr; const size_t lrow = (size_t)slot * T + t;
    const float* sconv = p.in[7] + (size_t)(l * 16 + slot) * 3 * 512;
    u32x4_t xbr[2][4]; u32x2 xcr[4][4];
#pragma unroll
    for (int ks = 0; ks < 2; ++ks)
#pragma unroll
        for (int j = 0; j < 4; ++j) xbr[ks][j] = *(const u32x4_t*)(U + lru_row(lrow, t, 3 - j) * 512 + c8 * 64 + 32 * ks + 8 * fq);
#pragma unroll
    for (int mt = 0; mt < 4; ++mt)
#pragma unroll
        for (int j = 0; j < 4; ++j) xcr[mt][j] = *(const u32x2*)(U + lru_row(lrow, t, 3 - j) * 512 + c8 * 64 + 16 * mt + 4 * fq);
    bf16x8 bx[2];
#pragma unroll
    for (int ks = 0; ks < 2; ++ks) {
        const int cl = 32 * ks + 8 * fq;
        f32x4 a0 = *(const LAS f32x4*)(tbl + 256 + cl), a1 = *(const LAS f32x4*)(tbl + 256 + cl + 4);
#pragma unroll
        for (int j = 0; j < 4; ++j) { f32x4 x0, x1; lru_cvt8<SAMPLE>(xbr[ks][j], sconv, t, 3 - j, c8 * 64 + cl, x0, x1);
            a0 += *(const LAS f32x4*)(tbl + j * 64 + cl) * x0; a1 += *(const LAS f32x4*)(tbl + j * 64 + cl + 4) * x1; }
        bx[ks] = pack8(a0, a1);
    }
    bf16_t* LH = (bf16_t*)(p.ws + W_LH); bf16_t* LPR = (bf16_t*)(p.ws + W_LPR); float* Pagg = (float*)(p.ws + W_PAGG); float* Hagg = (float*)(p.ws + W_HAGG);
#pragma unroll
    for (int mt = 0; mt < 4; ++mt) {
        f32x4 ga = {0.f, 0.f, 0.f, 0.f}, gx = {0.f, 0.f, 0.f, 0.f};
        ga = MFMA16(wa[mt][0], bx[0], ga); ga = MFMA16(wa[mt][1], bx[1], ga);
        gx = MFMA16(wx[mt][0], bx[0], gx); gx = MFMA16(wx[mt][1], bx[1], gx);
        const int cl = 16 * mt + 4 * fq; const int ch = c8 * 64 + cl;
        f32x4 xc = *(const LAS f32x4*)(tbl + 256 + cl);
#pragma unroll
        for (int j = 0; j < 4; ++j) xc += *(const LAS f32x4*)(tbl + j * 64 + cl) * lru_cvt4<SAMPLE>(xcr[mt][j], sconv, t, 3 - j, ch);
        const f32x4 ba = *(const LAS f32x4*)(tbl + 320 + cl), bg = *(const LAS f32x4*)(tbl + 384 + cl), c8sp = *(const LAS f32x4*)(tbl + 448 + cl);
        f32x4 av, bv;
#pragma unroll
        for (int r = 0; r < 4; ++r) {
            const float ra = sigm(ga[r] + ba[r]), ig = sigm(gx[r] + bg[r]);
            const float log_a = c8sp[r] * ra; av[r] = __expf(log_a);
            const float x2 = 2.0f * log_a;
            const float em = x2 > -0.3f ? x2 * (1.f + x2 * (0.5f + x2 * ((1.f / 6.f) + x2 * ((1.f / 24.f) + x2 * ((1.f / 120.f) + x2 * (1.f / 720.f)))))) : __expf(x2) - 1.f;
            bv[r] = __builtin_amdgcn_sqrtf(-em) * ig * xc[r];
        }
#pragma unroll
        for (int d = 1; d < 16; d <<= 1) {
#pragma unroll
            for (int r = 0; r < 4; ++r) { const float ap = shup16(av[r], lane, d), bp = shup16(bv[r], lane, d);
                if (fr >= d) { bv[r] = av[r] * bp + bv[r]; av[r] = av[r] * ap; } }
        }
        st_bf4(LPR + lrow * 512 + ch, av); st_bf4(LH + lrow * 512 + ch, bv);
        if (fr == 15) { *(f32x4*)(Pagg + ((size_t)slot * NTG + tg) * 512 + ch) = av; *(f32x4*)(Hagg + ((size_t)slot * NTG + tg) * 512 + ch) = bv; }
    }
}

template <int BLK, bool SAMPLE>
DI void ret_out_item(int item, const Params& p, int l, int lane) {
    constexpr int NQG = BLK / 16, NCH = SAMPLE ? 1 : 32, T = SAMPLE ? 32 : 2048;
    const int fr = lane & 15, fq = lane >> 4;
    const int w = item % NQG, h = (item / NQG) & 7, n = (item / (NQG * 8)) % NCH, slot = item / (NQG * 8 * NCH);
    const bf16_t* QB = (const bf16_t*)(p.ws + U_QB); const bf16_t* KB = (const bf16_t*)(p.ws + U_KB); const bf16_t* ZB = (const bf16_t*)(p.ws + U_ZB);
    const bf16_t* VTB = (const bf16_t*)(p.ws + W_VTB); const bf16_t* SP = (const bf16_t*)(p.ws + W_SP);
    bf16_t* Y = (bf16_t*)(p.ws + W_Y);
    const size_t r0 = (size_t)slot * T + n * BLK; const size_t qrow = r0 + 16 * w + fr;
    const float lg = lg2gamma(h);
    const size_t hm0 = (((size_t)slot * 8 + h) * T + n * BLK) * 64; const size_t qhm = hm0 + (size_t)(16 * w + fr) * 64;
    bf16x8 qf[2]; qf[0] = ld8(QB + qhm + 8 * fq); qf[1] = ld8(QB + qhm + 8 * fq + 32);
    f32x4 pin[NQG];
    const int iq = 16 * w + fr;
#pragma unroll
    for (int mt = 0; mt < NQG; ++mt) {
        { const int mtc = mt <= w ? mt : w; const bf16_t* kp = KB + hm0 + (size_t)(16 * mtc + fr) * 64 + 8 * fq;
            f32x4 z = {0.f, 0.f, 0.f, 0.f}; z = MFMA16(ld8(kp), qf[0], z); z = MFMA16(ld8(kp + 32), qf[1], z);
#pragma unroll
            for (int r = 0; r < 4; ++r) { const int dlt = iq - (16 * mt + 4 * fq + r); pin[mt][r] = dlt >= 0 ? z[r] * __builtin_amdgcn_exp2f(lg * (float)dlt) : 0.f; } }
    }
    const float xi = exp2f(lg * (float)(iq + 1));
    f32x4 y[4];
#pragma unroll
    for (int et = 0; et < 4; ++et) {
        f32x4 ay = {0.f, 0.f, 0.f, 0.f};
#pragma unroll
        for (int ks = 0; ks < NQG / 2; ++ks) { const bf16_t* vp = VTB + (((size_t)slot * 8 + h) * NCH + n) * (size_t)(64 * BLK) + (size_t)(16 * et + fr) * BLK + 32 * ks + 4 * fq;
            ay = MFMA16(ld4x2(vp, vp + 16), pack8(pin[2 * ks], pin[2 * ks + 1]), ay); }
        const bf16_t* sp = SP + ((size_t)(slot * 8 + h) * NCH + n) * 4096 + (16 * et + fr) * 64 + 8 * fq;
        f32x4 ax = {0.f, 0.f, 0.f, 0.f}; ax = MFMA16(ld8(sp), qf[0], ax); ax = MFMA16(ld8(sp + 32), qf[1], ax);
        y[et] = ay + ax * xi;
    }
    float sum = 0.f;
#pragma unroll
    for (int et = 0; et < 4; ++et) sum += y[et][0] + y[et][1] + y[et][2] + y[et][3];
    sum += shx(sum, lane, 16); sum += shx(sum, lane, 32);
    const float mu = sum * (1.0f / 64.0f);
    float vs = 0.f;
#pragma unroll
    for (int et = 0; et < 4; ++et)
#pragma unroll
        for (int r = 0; r < 4; ++r) { const float d = y[et][r] - mu; vs += d * d; }
    vs += shx(vs, lane, 16); vs += shx(vs, lane, 32);
    const float rs = rsqrtf(vs * (1.0f / 64.0f) + 1e-5f);
#pragma unroll
    for (int et = 0; et < 4; ++et) { const int col = h * 64 + 16 * et + 4 * fq;
        const f32x4 gn = *(const f32x4*)(p.in[11] + (size_t)l * 512 + col); const f32x4 z = ld_bf4(ZB + qhm + 16 * et + 4 * fq);
        f32x4 o; o.x = (y[et].x - mu) * rs * gn.x * z.x; o.y = (y[et].y - mu) * rs * gn.y * z.y; o.z = (y[et].z - mu) * rs * gn.z * z.z; o.w = (y[et].w - mu) * rs * gn.w * z.w;
        st_bf4(Y + qrow * 1536 + 512 + col, o); }
}

template <int BLK, bool SAMPLE>
DI void phase_mix1(const Params& p, int l, const Grp& g, LAS unsigned char* lds, int rep) {
    constexpr int NCH = SAMPLE ? 1 : 32, T = SAMPLE ? 32 : 2048;
    const int nslot = 16;
    const int nAB = nslot * NCH * 4, nR = nslot * NCH * 32, nL = nslot * (T / 16) * 8;
    const int tidl = tid_l(); const int wid = __builtin_amdgcn_readfirstlane(tidl >> 6), lane = tidl & 63;
    const int bid = bid_l();
    if (!SAMPLE && gridDim.x == 256) {
        const int x = bid & 7, j = bid >> 3;
        for (int k = 0; k < 8; ++k) { const int sidx = x + 8 * k; attn_block<BLK, SAMPLE>(((sidx >> 2) * NCH + ((j + 4 * k) & 31)) * 4 + (sidx & 3), p, l, tidl, lds); }
    } else
    for (int it = bid; it < nAB; it += gridDim.x) attn_block<BLK, SAMPLE>(it, p, l, tidl, lds);
    if (rep) return;
    const int gw = bid * 8 + wid, nw = gridDim.x * 8;
    constexpr int NCHAIN = 16 * 8 * 4;
    int chain_id, lw, lstride;
    if (gridDim.x == 256) { chain_id = wid < 2 ? bid * 2 + wid : -1; lw = bid * 6 + wid - 2; lstride = 1536; }
    else { chain_id = gw < NCHAIN ? gw : -1; lw = gw - NCHAIN; lstride = nw - NCHAIN; }
    if (chain_id >= 0) { ret_chain<BLK, SAMPLE>(chain_id, p, l, lane, p.out + (SAMPLE ? O_RS + (size_t)l * 16 * 8 * 4096 : O_RP + ((size_t)l * 32 + g.seq0) * 8 * 4096)); return; }
    LAS float* tbl = (LAS float*)(lds + AT_TAB + wid * 2048);
    bf16x8 wa[4][2], wx[4][2];
    { const int c8 = lw & 7, fr = lane & 15, fq = lane >> 4; const int ch = c8 * 64 + lane;
      const float* cw = p.in[12] + (size_t)l * 4 * 512;
      const float v0 = cw[ch], v1 = cw[512 + ch], v2 = cw[1024 + ch], v3 = cw[1536 + ch], v4 = p.in[13][(size_t)l * 512 + ch], v5 = p.in[15][(size_t)l * 512 + ch],
                  v6 = p.in[17][(size_t)l * 512 + ch], v7 = ((const float*)(p.ws + W_ROPE) + 131072)[(size_t)l * 512 + ch];
      tbl[lane] = v0; tbl[64 + lane] = v1; tbl[128 + lane] = v2; tbl[192 + lane] = v3; tbl[256 + lane] = v4; tbl[320 + lane] = v5; tbl[384 + lane] = v6; tbl[448 + lane] = v7;
      const bf16_t* WgT = (const bf16_t*)(p.ws + W_WG);
#pragma unroll
      for (int mt = 0; mt < 4; ++mt)
#pragma unroll
          for (int ks = 0; ks < 2; ++ks) { wa[mt][ks] = ld8(WgT + (size_t)((l * 2 + 0) * 8 + c8) * 4096 + (16 * mt + fr) * 64 + 8 * fq + 32 * ks);
              wx[mt][ks] = ld8(WgT + (size_t)((l * 2 + 1) * 8 + c8) * 4096 + (16 * mt + fr) * 64 + 8 * fq + 32 * ks); } }
#pragma unroll 1
    for (int it = lw; it < nL; it += lstride) { LAS float* tb2 = tbl; asm volatile("" : "+v"(tb2));
        lru_item<BLK, SAMPLE>(it, p, l, lane, tb2, wa, wx); }
}
template <int BLK, bool SAMPLE>
DI void phase_scan(const Params& p, int l, const Grp& g) {
    constexpr int NCH = SAMPLE ? 1 : 32, T = SAMPLE ? 32 : 2048, NTG = T / 16;
    const int nslot = 16;
    const size_t gt = (size_t)bid_l() * 512 + tid_l(), gn = (size_t)gridDim.x * 512;
    float* Pagg = (float*)(p.ws + W_PAGG); float* Hagg = (float*)(p.ws + W_HAGG); float* Carry = (float*)(p.ws + W_CARRY);
    float* lruout = p.out + (SAMPLE ? O_LS + (size_t)l * 16 * 512 : O_LP + ((size_t)l * 32 + g.seq0) * 512);
    { const int tidl = tid_l(); const int wid = __builtin_amdgcn_readfirstlane(tidl >> 6), lane = tidl & 63;
      if (wid == 7) {
        constexpr int TB = NTG < 32 ? NTG : 32;
        for (int w = bid_l(); w < nslot * 8; w += gridDim.x) {
            const int slot = w >> 3, ch = (w & 7) * 64 + lane;
            float hh = SAMPLE ? p.in[8][(size_t)(l * 16 + slot) * 512 + ch] : 0.f;
            const size_t b = (size_t)slot * NTG * 512 + ch;
            for (int t0 = 0; t0 < NTG; t0 += TB) {
                float pa[TB], ha[TB];
#pragma unroll
                for (int i = 0; i < TB; ++i) { pa[i] = Pagg[b + (size_t)(t0 + i) * 512]; ha[i] = Hagg[b + (size_t)(t0 + i) * 512]; }
#pragma unroll
                for (int i = 0; i < TB; ++i) { Carry[b + (size_t)(t0 + i) * 512] = hh; hh = pa[i] * hh + ha[i]; }
            }
            lruout[(size_t)slot * 512 + ch] = hh;
        }
      } }
}
template <int BLK, bool SAMPLE>
DI void phase_mix2(const Params& p, int l, const Grp& g) {
    constexpr int NQG = BLK / 16, NCH = SAMPLE ? 1 : 32, T = SAMPLE ? 32 : 2048, NTG = T / 16;
    const int nslot = 16;
    const int nR = nslot * NCH * 8 * NQG;
    const int tidl = tid_l(); const int wid = __builtin_amdgcn_readfirstlane(tidl >> 6), lane = tidl & 63;
    const int gw = bid_l() * 8 + wid, nw = gridDim.x * 8;
    for (int it = gw; it < nR; it += nw) ret_out_item<BLK, SAMPLE>(it, p, l, lane);
    const bf16_t* ZC = (const bf16_t*)(p.ws + U_ZC); bf16_t* Y = (bf16_t*)(p.ws + W_Y);
    const bf16_t* LH = (const bf16_t*)(p.ws + W_LH); const bf16_t* LPR = (const bf16_t*)(p.ws + W_LPR); const float* Carry = (const float*)(p.ws + W_CARRY);
    const size_t gt = (size_t)bid_l() * 512 + tid_l(), gn = (size_t)gridDim.x * 512;
    for (size_t i = gt; i < (size_t)g.rows * 128; i += gn) { const size_t lrow = i >> 7; const int ch = (int)(i & 127) * 4;
        const int slot = (int)(lrow / T), t = (int)(lrow % T);
        const f32x4 c = *(const f32x4*)(Carry + ((size_t)slot * NTG + (t >> 4)) * 512 + ch);
        const f32x4 hv = ld_bf4(LPR + lrow * 512 + ch) * c + ld_bf4(LH + lrow * 512 + ch);
        st_bf4(Y + lrow * 1536 + 1024 + ch, hv * ld_bf4(ZC + lrow * 512 + ch)); }
}
DI void phase_ln(const Params& p, int l, const Grp& g) {
    const bf16_t* R2 = (const bf16_t*)(p.ws + W_RF); bf16_t* xb = (bf16_t*)(p.ws + W_XB);
    float* ydst = p.out + (g.sample ? O_YS : O_YP + g.grow0 * DM);
    const float* lg = p.in[21] + (size_t)l * DM; const float* lb = p.in[22] + (size_t)l * DM;
    const int tidl = tid_l(); const int wid = __builtin_amdgcn_readfirstlane(tidl >> 6), lane = tidl & 63;
    const int nwv = gridDim.x * 8;
    for (int row0 = bid_l() * 8 + wid; row0 < g.rows; row0 += 4 * nwv) {
        f32x4 v[4][4]; float s[4], q[4];
#pragma unroll
        for (int j = 0; j < 4; ++j) { const int row = row0 + j * nwv < g.rows ? row0 + j * nwv : row0; s[j] = 0.f;
#pragma unroll
            for (int i = 0; i < 4; ++i) { v[j][i] = ld_bf4(R2 + (size_t)row * DM + i * 256 + lane * 4); s[j] += v[j][i].x + v[j][i].y + v[j][i].z + v[j][i].w; } }
#pragma unroll
        for (int d = 1; d < 64; d <<= 1)
#pragma unroll
            for (int j = 0; j < 4; ++j) s[j] += shx(s[j], lane, d);
#pragma unroll
        for (int j = 0; j < 4; ++j) { const float mu = s[j] * (1.0f / 1024.0f); s[j] = mu; q[j] = 0.f;
#pragma unroll
            for (int i = 0; i < 4; ++i) { const f32x4 d = v[j][i] - mu; q[j] += d.x * d.x + d.y * d.y + d.z * d.z + d.w * d.w; } }
#pragma unroll
        for (int d = 1; d < 64; d <<= 1)
#pragma unroll
            for (int j = 0; j < 4; ++j) q[j] += shx(q[j], lane, d);
#pragma unroll
        for (int j = 0; j < 4; ++j) { const int row = row0 + j * nwv; if (row < g.rows) { const float rs = rsqrtf(q[j] * (1.0f / 1024.0f) + 1e-5f);
#pragma unroll
            for (int i = 0; i < 4; ++i) { const int col = i * 256 + lane * 4; const f32x4 o = (v[j][i] - s[j]) * rs * *(const f32x4*)(lg + col) + *(const f32x4*)(lb + col);
                if (l == 0) st_bf4(xb + (size_t)row * DM + col, o); else *(f32x4*)(ydst + (size_t)row * DM + col) = o; } } }
    }
}

#define XB_TMO      128
#define XB_XCNT(j)  (256  + 64 * (j))
#define XB_XSUB(j)  (1280 + 64 * (j))
#define XB_XGEN(j)  (2304 + 64 * (j))
#define XB_TOP      3328
#define XB_TOPGEN   3392
#define XCD_BAR_WORDS 3456
#define XB_SPIN_CAP (1u << 18)
DI unsigned xb_ld(unsigned* p)              { return __hip_atomic_load(p, __ATOMIC_RELAXED, __HIP_MEMORY_SCOPE_AGENT); }
DI unsigned xb_add(unsigned* p, unsigned v) { return __hip_atomic_fetch_add(p, v, __ATOMIC_RELAXED, __HIP_MEMORY_SCOPE_AGENT); }
DI unsigned xb_xcc_id() { return (unsigned)__builtin_amdgcn_s_getreg((3 << 11) | 20) & 0xFu; }
#define XB_SPIN(cond, bar) do { unsigned _sp = 0; while (cond) { __builtin_amdgcn_s_sleep(1); \
    if ((++_sp & 255u) == 0u) { if (xb_ld(&(bar)[XB_TMO])) break; if (_sp > XB_SPIN_CAP) { atomicAdd(&(bar)[XB_TMO], 1u); break; } } } } while (0)
struct XcdBarrier { unsigned* bar; unsigned x; volatile LAS unsigned* st; };
DI XcdBarrier xcd_barrier_post(unsigned* bar, volatile LAS unsigned* st) {
    XcdBarrier b; b.bar = bar; b.x = xb_xcc_id(); b.st = st;
    if (threadIdx.x == 0) (void)xb_add(&bar[XB_XCNT(b.x)], 1u);
    return b;
}
DI void xcd_barrier_complete(unsigned* bar, unsigned x, unsigned& nloc, unsigned& nx) {
    const unsigned G = gridDim.x * gridDim.y * gridDim.z;
    unsigned sum, cnt, mine, sp = 0u;
    for (;;) {
        sum = 0u; cnt = 0u; mine = 0u;
#pragma unroll
        for (unsigned j = 0; j < 16; ++j) { const unsigned c = xb_ld(&bar[XB_XCNT(j)]); sum += c; cnt += (c > 0u) ? 1u : 0u; mine = (j == x) ? c : mine; }
        if (sum == G) break;
        __builtin_amdgcn_s_sleep(1);
        if ((++sp & 255u) == 0u) { if (xb_ld(&bar[XB_TMO])) break; if (sp > XB_SPIN_CAP) { atomicAdd(&bar[XB_TMO], 1u); break; } }
    }
    nloc = mine > 0u ? mine : 1u; nx = cnt > 0u ? cnt : 1u;
}
DI void xcd_barrier(const XcdBarrier& b) {
    asm volatile("s_waitcnt vmcnt(0)" ::: "memory");
    __syncthreads();
    if (threadIdx.x == 0) {
        unsigned* bar = b.bar;
        __builtin_amdgcn_s_waitcnt(0);
        unsigned nloc = b.st[0], nx = b.st[1];
        if (nloc == 0u) { xcd_barrier_complete(bar, b.x, nloc, nx); b.st[0] = nloc; b.st[1] = nx; }
        const unsigned old = xb_add(&bar[XB_XSUB(b.x)], 1u);
        const unsigned gen = old / nloc;
        if (old + 1u == (gen + 1u) * nloc) {
            __builtin_amdgcn_fence(__ATOMIC_RELEASE, "agent");
            asm volatile("s_waitcnt vmcnt(0)" ::: "memory");
            const unsigned og = xb_add(&bar[XB_TOP], 1u);
            const unsigned tg = og / nx;
            if (og + 1u == (tg + 1u) * nx) xb_add(&bar[XB_TOPGEN], 1u);
            else XB_SPIN(xb_ld(&bar[XB_TOPGEN]) == tg, bar);
            __builtin_amdgcn_fence(__ATOMIC_ACQUIRE, "agent");
            xb_add(&bar[XB_XGEN(b.x)], 1u);
            asm volatile("s_waitcnt vmcnt(0)" ::: "memory");
        } else {
            XB_SPIN(xb_ld(&bar[XB_XGEN(b.x)]) == gen, bar);
            __builtin_amdgcn_fence(__ATOMIC_ACQUIRE, "agent");
            asm volatile("s_waitcnt vmcnt(0)" ::: "memory");
        }
    }
    __syncthreads();
}
#ifndef PHMASK
#define PHMASK 511
#endif
#ifndef DUPMASK
#define DUPMASK 0
#endif
__global__ void __launch_bounds__(512, 2) fwd_megakernel(Params p0) {
    extern __shared__ __attribute__((aligned(16))) unsigned char smem[];
    cg::grid_group grid = cg::this_grid();
    LAS unsigned char* lds = (LAS unsigned char*)smem;
    volatile LAS unsigned* xst = (volatile LAS unsigned*)(lds + pg8::STAGE_BYTES);
    if (threadIdx.x == 0) { xst[0] = 0u; xst[1] = 0u; xst[2] = 0u; xst[3] = 0u; }
    __syncthreads();
    const XcdBarrier xbar = xcd_barrier_post((unsigned*)(p0.ws + W_BAR), xst);
    const int ph_lo = p0.ph_lo, ph_hi = p0.ph_hi;
    for (int ph = ph_lo; ph < ph_hi; ++ph) {
        typedef const Params __attribute__((address_space(4))) CParams;
        CParams* pp = (CParams*)__builtin_amdgcn_kernarg_segment_ptr();
        asm volatile("" : "+s"(pp));
#if defined(__HIP_DEVICE_COMPILE__)
        const Params p = *pp;
#else
        const Params p = p0;
#endif
        if (ph == 0) { if (PHMASK & 256) phase_prep(p, (float*)smem); }
        else for (int rep = 0; rep < (((DUPMASK >> ((ph - 1) & 7)) & 1) ? 2 : 1); ++rep) {
            if (rep) xcd_barrier(xbar);
            const int q = ph - 1, k = q & 7, l = (q >> 3) & 1, gi = q >> 4;
            const Grp g = mkgrp(gi);
            pg8::StaticOrder S;
            if (k == 0 && (PHMASK & 1)) {
                EpiIn E; E.ws = p.ws;
                E.SK = (bf16_t*)(p.ws + W_SK) + (size_t)l * 16 * 576 * 512; E.SVT = (bf16_t*)(p.ws + W_SVT) + (size_t)l * 16 * 512 * 576;
                E.outK = p.out + (g.sample ? O_KS + (size_t)l * 16 * 32 * 512 : O_KP + (size_t)l * 32 * 512 * 512);
                E.outV = p.out + (g.sample ? O_VS + (size_t)l * 16 * 32 * 512 : O_VP + (size_t)l * 32 * 512 * 512);
                E.outConv = p.out + (g.sample ? O_CS + (size_t)l * 16 * 3 * 512 : O_CP + (size_t)l * 32 * 3 * 512);
                E.rope = (const float*)(p.ws + W_ROPE); E.sample = g.sample; E.seq0 = g.seq0; E.T = g.T; E.blk = g.sample ? 32 : 64; E.nch = g.sample ? 1 : 32;
                pg8::Gemm gm{(const bf16_t*)(p.ws + W_XB), (const bf16_t*)(p.ws + W_WIN) + (size_t)l * NIN * DM, g.rows, NIN, DM};
                S.init(gm.M, gm.N, gridDim.x, bid_l()); pg8::gemm_phase(lds, gm, S, E);
            } else if (k == 1 && (PHMASK & 2)) { if (g.sample) phase_mix1<32, true>(p, l, g, lds, 0); else phase_mix1<64, false>(p, l, g, lds, 0);
            } else if (k == 2 && (PHMASK & 4)) { if (g.sample) phase_scan<32, true>(p, l, g); else phase_scan<64, false>(p, l, g);
            } else if (k == 3 && (PHMASK & 8)) { if (g.sample) phase_mix2<32, true>(p, l, g); else phase_mix2<64, false>(p, l, g);
            } else if (k == 4 && (PHMASK & 16)) {
                EpiMerge E; E.U = (const bf16_t*)(p.ws + U_GS); E.Mb = (bf16_t*)(p.ws + W_MB);
                pg8::Gemm gm{(const bf16_t*)(p.ws + W_Y), (const bf16_t*)(p.ws + W_WBR) + (size_t)l * DM * 1536, g.rows, DM, 1536};
                S.init(gm.M, gm.N, gridDim.x, bid_l()); pg8::gemm_phase(lds, gm, S, E);
            } else if (k == 5 && (PHMASK & 32)) {
                EpiOut E; E.xb = (const bf16_t*)(p.ws + W_XB); E.Rb = (bf16_t*)(p.ws + W_RB);
                pg8::Gemm gm{(const bf16_t*)(p.ws + W_MB), (const bf16_t*)(p.ws + W_WOUT) + (size_t)l * DM * DM, g.rows, DM, DM};
                S.init(gm.M, gm.N, gridDim.x, bid_l()); pg8::gemm_phase(lds, gm, S, E);
                EpiPE E2; E2.PE = (bf16_t*)(p.ws + W_PE);
                pg8::Gemm g2{(const bf16_t*)(p.ws + W_PB) + (size_t)l * RG * 256, (const bf16_t*)(p.ws + W_WPE) + (size_t)l * DM * 256, g.rows, DM, 256};
                S.init(g2.M, g2.N, gridDim.x, bid_l()); pg8::gemm_phase(lds, g2, S, E2);
            } else if (k == 6 && (PHMASK & 64)) {
                EpiGate E; E.PE = (const bf16_t*)(p.ws + W_PE); E.Rb = (const bf16_t*)(p.ws + W_RB); E.R2 = (bf16_t*)(p.ws + W_RF);
                pg8::Gemm gm{(const bf16_t*)(p.ws + W_RB), (const bf16_t*)(p.ws + W_WPG) + (size_t)l * DM * DM, g.rows, DM, DM};
                S.init(gm.M, gm.N, gridDim.x, bid_l()); pg8::gemm_phase(lds, gm, S, E);
            } else if (PHMASK & 128) {
                phase_ln(p, l, g);
                if (l == 1 && gi + 1 < NGROUP) group_convert(p, gi + 1);
            }
        }
        if (ph + 1 < ph_hi) { if (ph == ph_lo) grid.sync(); else xcd_barrier(xbar); }
    }
}

extern "C" void kernel_launch(void* const* d_in, const int* in_sizes, int n_in, void* d_out, int out_size, void* d_ws, size_t ws_size, hipStream_t stream) {
    static int grid_blocks = 0;
    constexpr size_t kDynLds = pg8::STAGE_BYTES + 16;
    if (!grid_blocks) {
        if (n_in != 25 || ws_size < W_END) { fprintf(stderr, "kernel_launch: unexpected n_in %d or ws_size %zu (< %zu)\n", n_in, ws_size, (size_t)W_END); grid_blocks = -1; return; }
        int dev = 0, cus = 0, per_cu = 0;
        (void)hipGetDevice(&dev);
        (void)hipDeviceGetAttribute(&cus, hipDeviceAttributeMultiprocessorCount, dev);
        (void)hipFuncSetAttribute((const void*)fwd_megakernel, hipFuncAttributeMaxDynamicSharedMemorySize, (int)kDynLds);
        (void)hipOccupancyMaxActiveBlocksPerMultiprocessor(&per_cu, (const void*)fwd_megakernel, 512, kDynLds);
        if (per_cu < 1) per_cu = 1;
        grid_blocks = cus * per_cu;
        if (grid_blocks > 256) grid_blocks = 256;
    }
    if (grid_blocks < 0) return;
    Params p{};
    for (int i = 0; i < 25; ++i) p.in[i] = (const float*)d_in[i];
    p.out = (float*)d_out; p.ws = (unsigned char*)d_ws; p.ph_lo = 0; p.ph_hi = 1 + NGROUP * 16;
    (void)hipMemsetAsync((unsigned char*)d_ws + W_BAR, 0, XCD_BAR_WORDS * 4, stream);
    void* args[] = {&p};
    hipError_t e = hipLaunchCooperativeKernel((const void*)fwd_megakernel, dim3(grid_blocks), dim3(512), args, kDynLds, stream);
    if (e != hipSuccess) fprintf(stderr, "cooperative launch failed: %s (grid %d)\n", hipGetErrorString(e), grid_blocks);
}
```
